# Optimizing an MI355X kernel written in HIP

```python
import math
import jax
import jax.numpy as jnp
from jax import lax
import numpy as np


D_MODEL = 1024
BATCH = 1
SEQ = 16384
DEPTH = 2

GRID_W = 64
CTX_LEN = 256
N_MIXERS = 2
N_GLA = (DEPTH + N_MIXERS - 1) // N_MIXERS
N_DIFF = DEPTH // N_MIXERS
GLA_HEADS = 4
GLA_DK = D_MODEL // 2 // GLA_HEADS
GLA_DV = D_MODEL // GLA_HEADS
GLA_GATE_RANK = 16
GLA_GATE_NORM = 16.0
GLA_CHUNK = 64
DIFF_HEAD_DIM = 64
DIFF_HEADS = D_MODEL // (2 * DIFF_HEAD_DIM)
ROPE_BASE = 10000.0
Q_BLOCK = 128
D_FF = 2816
CONV_WIDTH = 3
N_MOD = 6
EPS = 1e-6

kernel_name = 'hybrid_gla_diffattn_convffn_dit'


def rmsnorm(x, g):
    xf = x.astype(jnp.float32)
    y = xf * lax.rsqrt(jnp.mean(xf * xf, axis=-1, keepdims=True) + EPS)
    return y.astype(x.dtype) * g


def split_heads(t, heads):
    bsz, length, _ = t.shape
    return t.reshape(bsz, length, heads, -1).transpose(0, 2, 1, 3)


def merge_heads(t):
    bsz, heads, length, dim = t.shape
    return t.transpose(0, 2, 1, 3).reshape(bsz, length, heads * dim)


def axial_rope_tables(n_tokens, dtype):
    rows = n_tokens // GRID_W
    row = jnp.repeat(jnp.arange(rows, dtype=jnp.float32), GRID_W)
    col = jnp.tile(jnp.arange(GRID_W, dtype=jnp.float32), rows)
    quarter = DIFF_HEAD_DIM // 4
    inv = ROPE_BASE ** (-jnp.arange(quarter, dtype=jnp.float32) / quarter)
    ang_r = row[:, None] * inv
    ang_c = col[:, None] * inv
    ang = jnp.concatenate([ang_r, ang_r, ang_c, ang_c], axis=-1)
    return jnp.cos(ang).astype(dtype), jnp.sin(ang).astype(dtype)


def apply_axial_rope(x, cos, sin):
    xs = x.reshape(x.shape[:-1] + (2, 2, DIFF_HEAD_DIM // 4))
    rot = jnp.stack([-xs[..., 1, :], xs[..., 0, :]], axis=-2).reshape(x.shape)
    return x * cos + rot * sin


def gla_chunk_scan(q, k, v, log_g, s0):
    bsz, heads, length, _ = q.shape
    n_chunks = length // GLA_CHUNK

    def to_chunks(a):
        return a.reshape(bsz, heads, n_chunks, GLA_CHUNK, a.shape[-1]).transpose(2, 0, 1, 3, 4)

    mask = jnp.tril(jnp.ones((GLA_CHUNK, GLA_CHUNK), dtype=bool))[:, :, None]

    def step(state, inp):
        qb, kb, vb, gb = inp
        b = jnp.cumsum(gb, axis=2)
        rel = jnp.where(mask, b[:, :, :, None, :] - b[:, :, None, :, :], -jnp.inf)
        scores = jnp.einsum('bhtd,bhsd,bhtsd->bhts', qb, kb, jnp.exp(rel))
        out = (jnp.einsum('bhts,bhsv->bhtv', scores, vb)
               + jnp.einsum('bhtd,bhdv->bhtv', qb * jnp.exp(b), state))
        b_last = b[:, :, -1:, :]
        state = (jnp.exp(b_last[:, :, 0, :])[..., None] * state
                 + jnp.einsum('bhsd,bhsv->bhdv', kb * jnp.exp(b_last - b), vb))
        return state, out

    state, out = lax.scan(step, s0, (to_chunks(q), to_chunks(k), to_chunks(v), to_chunks(log_g)))
    out = out.transpose(1, 2, 0, 3, 4).reshape(bsz, heads, length, v.shape[-1])
    return out, state


def gla_mixer(hx, hc, wq, wk, wv, wr, wg1, wg2, bg, gn, wo, need_ctx):
    f32 = jnp.float32

    def project(h):
        q = split_heads(h @ wq, GLA_HEADS).astype(f32) * GLA_DK ** -0.5
        k = split_heads(h @ wk, GLA_HEADS).astype(f32)
        v = split_heads(h @ wv, GLA_HEADS).astype(f32)
        log_g = [split_heads(jax.nn.log_sigmoid(((h @ wg1[d]) @ wg2[d] + bg[d]).astype(f32))
                             / GLA_GATE_NORM, GLA_HEADS) for d in range(2)]
        return q, k, v, log_g

    def bidirectional(q, k, v, log_g, s_fwd, s_bwd):
        o_f, st_f = gla_chunk_scan(q, k, v, log_g[0], s_fwd)
        flip = lambda a: jnp.flip(a, axis=2)
        o_b, st_b = gla_chunk_scan(flip(q), flip(k), flip(v), flip(log_g[1]), s_bwd)
        return o_f + flip(o_b), st_f, st_b

    def readout(h, o):
        o = merge_heads(rmsnorm(o, gn)).astype(h.dtype) * jax.nn.silu(h @ wr)
        return o @ wo

    zero = jnp.zeros((hx.shape[0], GLA_HEADS, GLA_DK, GLA_DV), f32)
    qc, kc, vc, gc = project(hc)
    oc, ctx_fwd, ctx_bwd = bidirectional(qc, kc, vc, gc, zero, zero)
    qx, kx, vx, gx = project(hx)
    ox, _, _ = bidirectional(qx, kx, vx, gx, ctx_fwd, ctx_bwd)
    dx = readout(hx, ox)
    dc = readout(hc, oc) if need_ctx else None
    return dx, dc


def diff_mixer(hx, hc, wq, wk, wv, lq1, lk1, lq2, lk2, subln, wo, lambda_init, need_ctx):
    f32 = jnp.float32
    scale = DIFF_HEAD_DIM ** -0.5
    lam = (jnp.exp(jnp.sum(lq1 * lk1).astype(f32)) - jnp.exp(jnp.sum(lq2 * lk2).astype(f32))
           + lambda_init)

    def qkv(h):
        bsz, length, _ = h.shape
        q = (h @ wq).reshape(bsz, length, DIFF_HEADS, 2, DIFF_HEAD_DIM).transpose(3, 0, 2, 1, 4)
        k = (h @ wk).reshape(bsz, length, DIFF_HEADS, 2, DIFF_HEAD_DIM).transpose(3, 0, 2, 1, 4)
        v = split_heads(h @ wv, DIFF_HEADS)
        return q, k, v

    def diff_attend(q, k, v):
        s = jnp.einsum('nbhqd,nbhkd->nbhqk', q, k).astype(f32) * scale
        p = jax.nn.softmax(s, axis=-1)
        return jnp.einsum('bhqk,bhkv->bhqv', p[0] - lam * p[1], v)

    def readout(o, dtype):
        o = rmsnorm(o, subln) * (1.0 - lambda_init)
        return merge_heads(o).astype(dtype) @ wo

    qc, kc, vc = qkv(hc)
    qx, kx, vx = qkv(hx)
    bsz, n_lat = hx.shape[0], hx.shape[1]
    cos, sin = axial_rope_tables(n_lat, qx.dtype)
    qx = apply_axial_rope(qx, cos, sin)
    kx = apply_axial_rope(kx, cos, sin)
    k_all = jnp.concatenate([kc, kx], axis=3)
    v_all = jnp.concatenate([vc, vx], axis=2).astype(f32)
    n_blocks = n_lat // Q_BLOCK
    q_blocks = qx.reshape(2, bsz, DIFF_HEADS, n_blocks, Q_BLOCK, DIFF_HEAD_DIM).transpose(3, 0, 1, 2, 4, 5)
    o_blocks = lax.map(lambda qb: diff_attend(qb, k_all, v_all), q_blocks)
    ox = o_blocks.transpose(1, 2, 0, 3, 4).reshape(bsz, DIFF_HEADS, n_lat, 2 * DIFF_HEAD_DIM)
    dx = readout(ox, hx.dtype)
    dc = readout(diff_attend(qc, kc, vc.astype(f32)), hc.dtype) if need_ctx else None
    return dx, dc


def conv_ffn(h, w_up, w_conv, b_conv, w_down):
    u = h @ w_up
    up = jnp.pad(u, ((0, 0), (1, 1), (0, 0)))
    u = up[:, :-2] * w_conv[0] + up[:, 1:-1] * w_conv[1] + up[:, 2:] * w_conv[2] + b_conv
    a, b = jnp.split(u, 2, axis=-1)
    return (jax.nn.silu(a) * b) @ w_down


def setup_inputs(seed: int = 0) -> dict:
    key = jax.random.key(seed)
    ks = iter(jax.random.split(key, 40))
    f32 = jnp.float32

    def nrm(shape, fan_in):
        return jax.random.normal(next(ks), shape, f32) * fan_in ** -0.5

    def gain(shape):
        return 1.0 + 0.02 * jax.random.normal(next(ks), shape, f32)

    def small(shape, s):
        return s * jax.random.normal(next(ks), shape, f32)

    D = D_MODEL
    return {
        'x': jax.random.normal(next(ks), (BATCH, SEQ, D), f32),
        'c': jax.random.normal(next(ks), (BATCH, D), f32),
        'ctx': jax.random.normal(next(ks), (BATCH, CTX_LEN, D), f32),
        'c_ctx': jax.random.normal(next(ks), (D,), f32),
        'mod_w': nrm((DEPTH, D, N_MOD * D), D),
        'mod_b': small((DEPTH, N_MOD * D), 0.01),
        'norm_mix': gain((DEPTH, D)),
        'norm_ffn': gain((DEPTH, D)),
        'gla_wq': nrm((N_GLA, D, GLA_HEADS * GLA_DK), D),
        'gla_wk': nrm((N_GLA, D, GLA_HEADS * GLA_DK), D),
        'gla_wv': nrm((N_GLA, D, GLA_HEADS * GLA_DV), D),
        'gla_wr': nrm((N_GLA, D, GLA_HEADS * GLA_DV), D),
        'gla_wg1': nrm((N_GLA, 2, D, GLA_GATE_RANK), D),
        'gla_wg2': nrm((N_GLA, 2, GLA_GATE_RANK, GLA_HEADS * GLA_DK), GLA_GATE_RANK),
        'gla_bg': small((N_GLA, 2, GLA_HEADS * GLA_DK), 0.1),
        'gla_norm': gain((N_GLA, GLA_DV)),
        'gla_wo': nrm((N_GLA, GLA_HEADS * GLA_DV, D), GLA_HEADS * GLA_DV),
        'diff_wq': nrm((N_DIFF, D, 2 * DIFF_HEADS * DIFF_HEAD_DIM), D),
        'diff_wk': nrm((N_DIFF, D, 2 * DIFF_HEADS * DIFF_HEAD_DIM), D),
        'diff_wv': nrm((N_DIFF, D, DIFF_HEADS * 2 * DIFF_HEAD_DIM), D),
        'diff_lq1': small((N_DIFF, DIFF_HEAD_DIM), 0.1),
        'diff_lk1': small((N_DIFF, DIFF_HEAD_DIM), 0.1),
        'diff_lq2': small((N_DIFF, DIFF_HEAD_DIM), 0.1),
        'diff_lk2': small((N_DIFF, DIFF_HEAD_DIM), 0.1),
        'diff_subln': gain((N_DIFF, 2 * DIFF_HEAD_DIM)),
        'diff_wo': nrm((N_DIFF, DIFF_HEADS * 2 * DIFF_HEAD_DIM, D), DIFF_HEADS * 2 * DIFF_HEAD_DIM),
        'ffn_wup': nrm((DEPTH, D, 2 * D_FF), D),
        'ffn_conv': nrm((DEPTH, CONV_WIDTH, 2 * D_FF), CONV_WIDTH),
        'ffn_conv_b': small((DEPTH, 2 * D_FF), 0.01),
        'ffn_wdown': nrm((DEPTH, D_FF, D), D_FF),
        'final_norm': gain((D,)),
    }


def reference(x, c, ctx, c_ctx, mod_w, mod_b, norm_mix, norm_ffn,
              gla_wq, gla_wk, gla_wv, gla_wr, gla_wg1, gla_wg2, gla_bg, gla_norm, gla_wo,
              diff_wq, diff_wk, diff_wv, diff_lq1, diff_lk1, diff_lq2, diff_lk2, diff_subln, diff_wo,
              ffn_wup, ffn_conv, ffn_conv_b, ffn_wdown, final_norm):
    silu_c = jax.nn.silu(c)[:, None, :]
    silu_cc = jax.nn.silu(c_ctx)
    for i in range(DEPTH):
        last = i == DEPTH - 1
        mx = jnp.split(silu_c @ mod_w[i] + mod_b[i], N_MOD, axis=-1)
        mc = jnp.split(silu_cc @ mod_w[i] + mod_b[i], N_MOD, axis=-1)
        hx = rmsnorm(x, norm_mix[i]) * (1 + mx[1]) + mx[0]
        hc = rmsnorm(ctx, norm_mix[i]) * (1 + mc[1]) + mc[0]
        j = i // N_MIXERS
        if i % N_MIXERS == 0:
            dx, dc = gla_mixer(hx, hc, gla_wq[j], gla_wk[j], gla_wv[j], gla_wr[j], gla_wg1[j],
                               gla_wg2[j], gla_bg[j], gla_norm[j], gla_wo[j], not last)
        else:
            lambda_init = 0.8 - 0.6 * math.exp(-0.3 * i)
            dx, dc = diff_mixer(hx, hc, diff_wq[j], diff_wk[j], diff_wv[j], diff_lq1[j], diff_lk1[j],
                                diff_lq2[j], diff_lk2[j], diff_subln[j], diff_wo[j], lambda_init, not last)
        x = x + mx[2] * dx
        x = x + mx[5] * conv_ffn(rmsnorm(x, norm_ffn[i]) * (1 + mx[4]) + mx[3],
                                 ffn_wup[i], ffn_conv[i], ffn_conv_b[i], ffn_wdown[i])
        if not last:
            ctx = ctx + mc[2] * dc
            ctx = ctx + mc[5] * conv_ffn(rmsnorm(ctx, norm_ffn[i]) * (1 + mc[4]) + mc[3],
                                         ffn_wup[i], ffn_conv[i], ffn_conv_b[i], ffn_wdown[i])
    return rmsnorm(x, final_norm)
```

```cpp
#include <hip/hip_runtime.h>
#include <hip/hip_cooperative_groups.h>
#include <cstdio>
#include <cstdint>
namespace cg = cooperative_groups;

#define LAS __attribute__((address_space(3)))
#define DI __device__ __forceinline__
typedef unsigned short bf16_t;
typedef short bf16x8 __attribute__((ext_vector_type(8)));
typedef float f32x2 __attribute__((ext_vector_type(2)));
typedef float f32x4 __attribute__((ext_vector_type(4)));
typedef float f32x16 __attribute__((ext_vector_type(16)));
typedef unsigned u32x2 __attribute__((ext_vector_type(2)));
typedef unsigned u32x4 __attribute__((ext_vector_type(4)));
typedef __bf16 bf16x2_t __attribute__((ext_vector_type(2)));

DI unsigned pk2(float lo, float hi) { f32x2 v = {lo, hi}; bf16x2_t b = __builtin_convertvector(v, bf16x2_t); return __builtin_bit_cast(unsigned, b); }
DI float bf2f(bf16_t b) { return __uint_as_float(((unsigned)b) << 16); }
DI float bflo(unsigned w) { return __uint_as_float(w << 16); }
DI float bfhi(unsigned w) { return __uint_as_float(w & 0xffff0000u); }
DI float silu_f(float x) { return x * __builtin_amdgcn_rcpf(1.f + __builtin_amdgcn_exp2f(-1.4426950408889634f * x)); }
DI int crow(int r, int hh) { return (r & 3) + 8 * (r >> 2) + 4 * hh; }
DI float wave_sum(float v) {
#pragma unroll
    for (int o = 1; o < 64; o <<= 1) v += __shfl_xor(v, o);
    return v;
}

constexpr int D = 1024, LX = 16384, LC = 256, MT = LX + LC;
constexpr int DFF = 2816, NUP = 5632;
constexpr float EPS = 1e-6f;
constexpr float LAMBDA_INIT = 0.35550906759297316f;
constexpr float QSCALE1 = 0.125f * 1.4426950408889634f;
constexpr int NSEG = 32;

constexpr size_t MiB = 1u << 20;
constexpr size_t WS_MISC = 0;
constexpr size_t WS_W = 4 * MiB;
constexpr size_t WS_BAR = 2 * MiB;
constexpr size_t W_P0 = WS_W, W_V0 = W_P0 + 2304 * 2048, W_O0 = W_V0 + 2 * MiB, W_UP0 = W_O0 + 2 * MiB, W_DN0 = W_UP0 + 11 * MiB;
constexpr size_t W_QK1 = W_DN0 + 5632 * 1024, W_V1 = W_QK1 + 4 * MiB, W_O1 = W_V1 + 2 * MiB, W_UP1 = W_O1 + 2 * MiB, W_DN1 = W_UP1 + 11 * MiB;
constexpr size_t WS_ACT0 = 54 * MiB, ACT0_PAD = 16384;
constexpr size_t WS_SB = WS_ACT0;
constexpr size_t WS_ACT1 = 88 * MiB;
constexpr size_t WS_R1 = 121 * MiB;
constexpr size_t R_Q0 = WS_R1, R_K0 = R_Q0 + (size_t)MT * 512 * 2, R_R0 = R_K0 + (size_t)MT * 512 * 2, R_VT = R_R0 + (size_t)MT * 1024 * 2, R_T0 = R_VT + (size_t)MT * 1024 * 2;
constexpr size_t R_Q1 = WS_R1, R_K1 = R_Q1 + (size_t)MT * 1024 * 2;
constexpr size_t R_G = WS_R1;
constexpr size_t WS_XC = 221 * MiB;
constexpr size_t WS_XR = 222 * MiB;
constexpr size_t WS_END = 255 * MiB;
static_assert(WS_XR + (size_t)MT * D * 2 <= WS_END, "XR");
static_assert(W_DN1 + 5632 * 1024 <= WS_ACT0, "weights");
static_assert(R_T0 + (size_t)MT * 32 * 4 <= WS_XC && R_G + (size_t)MT * DFF * 2 <= WS_XC, "R1");
static_assert((size_t)NSEG * 8 * 32768 * 4 <= WS_ACT1 - WS_SB, "SB");
constexpr int OFF_MOD = 0, OFF_SS = 32768, OFF_BIAS = 131072, OFF_GS = 172032, OFF_ROPE = 196608, OFF_LAM = 204800, OFF_ASEG = 212992;
constexpr int B_P0 = 0, B_V0 = 4608, B_UP0 = 6656, B_QK1 = 17920, B_V1 = 22016, B_UP1 = 24064;

struct Piece { const float* src; bf16_t* dst; int K, Nsrc, nrows, map; };
struct Params { const float* in[31]; float* out; unsigned char* ws; Piece pc[13]; };

namespace pg8 {
constexpr int BM = 256, BK = 64, HALF = 128, HTB = HALF * BK * 2, STAGE_BYTES = 8 * HTB, NXCD = 8, WGM = 4;
DI int lds_byte(int r, int c) { const int st = (r >> 4) * 2 + (c >> 5), rr = r & 15, cc = c & 31, ob = rr * 64 + cc * 2; return st * 1024 + (ob ^ (((ob >> 9) & 1) << 5)); }
DI void stage_rc(int b, int& R, int& C) { const int st = b / 1024, sb = b % 1024, swz = sb ^ (((sb >> 9) & 1) << 5); R = (st >> 1) * 16 + swz / 64; C = (st & 1) * 32 + (swz % 64) / 2; }
DI int perm32(int rho) { const int n = rho >> 4, i = rho & 15; return 8 * (i >> 2) + 4 * n + (i & 3); }

struct Unit { const char* A; const char* B; int pm, pn, kind, base, lo, hi; };

DI void tile_of(int wgid, int nM, int nN, int& pm, int& pn) {
    const int nwg = nM * nN;
    { const int q = nwg / NXCD, r = nwg % NXCD, xcd = wgid % NXCD, off = wgid / NXCD; wgid = (xcd < r ? xcd * (q + 1) : r * (q + 1) + (xcd - r) * q) + off; }
    const int nig = WGM * nN, gid = wgid / nig, fm = gid * WGM, gsz = (nM - fm) < WGM ? (nM - fm) : WGM;
    pm = fm + ((wgid % nig) % gsz); pn = (wgid % nig) / gsz;
}

struct Sched {
    const char *A0, *B0, *A1, *B1; int nM0, nN0, pm0, nM1, nN1, K, halo, G, c, bjm;
    DI bool next(int i, Unit& u) const {
        const long L = (long)i * G + c; const int n0 = nM0 * nN0, n1 = nM1 * nN1;
        if (L >= n0 + n1) return false;
        int pm, pn;
        if (L < n0) {
            tile_of((int)L, nM0, nN0, pm, pn); pm += pm0; u.kind = 0; u.pm = pm; u.pn = pn;
            if (halo) { const int base = pm < 2 ? 248 * pm : 256 + 248 * (pm - 2); u.base = base; u.lo = pm < 2 ? 0 : 256; u.hi = pm < 2 ? 256 : MT; u.A = A0 + ((long)base - 1) * K * 2; }
            else { u.base = 0; u.lo = 0; u.hi = 0; u.A = A0 + (size_t)pm * 256 * K * 2; }
            u.B = B0 + (size_t)pn * 256 * K * 2;
        } else {
            tile_of((int)(L - n0), nM1, nN1, pm, pn); u.kind = 1; u.pm = pm; u.pn = pn; u.base = 0; u.lo = 0; u.hi = 0;
            u.A = A1 + (size_t)pm * 256 * K * 2; u.B = B1 + (size_t)pn * 256 * K * 2;
        }
        return true;
    }
};

template <class Epi>
DI void gemm_phase(LAS unsigned char* lds, const Sched& S, const Epi& E) {
    int tid_ = threadIdx.x; asm volatile("" : "+v"(tid_)); const int tid = tid_, wid = __builtin_amdgcn_readfirstlane(tid >> 6), lane = tid & 63, wr = wid >> 2, wc = wid & 3, fr = lane & 15, fq = lane >> 4;
    const int K = S.K, nt = K / BK;
    unsigned voffA[2], voffB[2];
#pragma unroll
    for (int i = 0; i < 2; ++i) { int R, C; stage_rc(tid * 16 + i * 8192, R, C); const int Rb = S.bjm ? 64 * (R >> 5) + perm32(R & 31) : (R & ~31) + perm32(R & 31); const int Ra = S.halo ? 62 * (R >> 6) + 4 * (R & 15) + ((R >> 4) & 3) : R;
        voffA[i] = (unsigned)(Ra * K + C) * 2u; voffB[i] = (unsigned)(Rb * K + C) * 2u; }
    const size_t kstep = (size_t)(BK * 2);
    const size_t hstepB = S.bjm ? (size_t)32 * K * 2 : (size_t)HALF * K * 2;
    const size_t hstepA = S.halo ? (size_t)124 * K * 2 : (size_t)HALF * K * 2;
    const unsigned ldsw = (unsigned)wid * 1024u;
    const int aoff = lds_byte(wr * 64 + fr, fq * 8), boff = lds_byte(wc * 32 + fr, fq * 8);
#define PG8_SA(b, h) (((b) * 2 + (h)) * HTB)
#define PG8_SB(b, h) ((4 + (b) * 2 + (h)) * HTB)
#define PG8_STAGE(bufoff, gbase, voff) do { _Pragma("unroll") for (int _i = 0; _i < 2; ++_i) \
        __builtin_amdgcn_global_load_lds((const unsigned*)((const char*)(gbase) + (voff)[_i]), (LAS unsigned*)(lds + (bufoff) + ldsw + _i * 8192), 16, 0, 0); } while (0)
#define PG8_LDA(dst, b, h) do { _Pragma("unroll") for (int m = 0; m < 4; ++m) _Pragma("unroll") for (int k = 0; k < 2; ++k) dst[m][k] = *(const LAS bf16x8*)(lds + PG8_SA(b, h) + aoff + m * 2048 + k * 1024); } while (0)
#define PG8_LDB(dst, b, h) do { _Pragma("unroll") for (int n = 0; n < 2; ++n) _Pragma("unroll") for (int k = 0; k < 2; ++k) dst[n][k] = *(const LAS bf16x8*)(lds + PG8_SB(b, h) + boff + n * 2048 + k * 1024); } while (0)
#define PG8_MMA(ai, bj, At, Bt) do { __builtin_amdgcn_s_setprio(1); _Pragma("unroll") for (int m = 0; m < 4; ++m) _Pragma("unroll") for (int n = 0; n < 2; ++n) _Pragma("unroll") for (int k = 0; k < 2; ++k) \
        acc[ai][bj][m][n] = __builtin_amdgcn_mfma_f32_16x16x32_bf16(Bt[n][k], At[m][k], acc[ai][bj][m][n], 0, 0, 0); __builtin_amdgcn_s_setprio(0); } while (0)
#define PG8_WAIT_V(n) asm volatile("s_waitcnt vmcnt(" #n ")" ::: "memory")
#define PG8_WAIT_L(n) asm volatile("s_waitcnt lgkmcnt(" #n ")" ::: "memory")
#define PG8_BAR __builtin_amdgcn_s_barrier()
#define PG8_SCHED __builtin_amdgcn_sched_barrier(0)
    Unit cur, nxt; int ui = 0;
    if (!S.next(0, cur)) return;
    f32x4 acc[2][2][4][2];
#pragma unroll
    for (int a = 0; a < 2; ++a)
#pragma unroll
        for (int b = 0; b < 2; ++b)
#pragma unroll
            for (int m = 0; m < 4; ++m)
#pragma unroll
                for (int n = 0; n < 2; ++n) acc[a][b][m][n] = (f32x4){0.f, 0.f, 0.f, 0.f};
    bf16x8 At[4][2], B0[2][2], B1[2][2];
    const char* cA = cur.A; const char* cB = cur.B;
    PG8_STAGE(PG8_SB(0, 0), cB, voffB); PG8_STAGE(PG8_SB(0, 1), cB + hstepB, voffB); PG8_STAGE(PG8_SA(0, 0), cA, voffA); PG8_STAGE(PG8_SA(0, 1), cA + hstepA, voffA);
    if (wr == 1) PG8_BAR;
    PG8_WAIT_V(2); PG8_BAR;
    PG8_STAGE(PG8_SB(1, 0), cB + kstep, voffB); PG8_STAGE(PG8_SA(1, 0), cA + kstep, voffA); PG8_STAGE(PG8_SB(1, 1), cB + hstepB + kstep, voffB);
    PG8_WAIT_V(6); PG8_BAR;
    for (;;) {
        const bool has_next = S.next(ui + 1, nxt);
        const char* nA = has_next ? nxt.A : cA; const char* nB = has_next ? nxt.B : cB;
        for (int t = 0; t < nt; t += 2) {
            const bool last = (t == nt - 2);
            const char* a1 = cA + (size_t)(t + 1) * kstep;
            const char* a2 = last ? nA : cA + (size_t)(t + 2) * kstep; const char* b2 = last ? nB : cB + (size_t)(t + 2) * kstep;
            const char* a3 = a2 + kstep; const char* b3 = b2 + kstep;
            PG8_LDB(B0, 0, 0); PG8_LDB(B1, 0, 1); PG8_SCHED; PG8_LDA(At, 0, 0); PG8_STAGE(PG8_SA(1, 1), a1 + hstepA, voffA);
            PG8_WAIT_V(8); PG8_WAIT_L(0); PG8_BAR; PG8_MMA(0, 0, At, B0); PG8_MMA(0, 1, At, B1); PG8_BAR; PG8_SCHED;
            PG8_LDA(At, 0, 1); PG8_STAGE(PG8_SB(0, 0), b2, voffB); PG8_STAGE(PG8_SB(0, 1), b2 + hstepB, voffB); PG8_STAGE(PG8_SA(0, 0), a2, voffA);
            PG8_WAIT_V(8); PG8_WAIT_L(0); PG8_BAR; PG8_MMA(1, 0, At, B0); PG8_MMA(1, 1, At, B1); PG8_BAR; PG8_SCHED;
            PG8_LDB(B0, 1, 0); PG8_LDB(B1, 1, 1); PG8_SCHED; PG8_LDA(At, 1, 0); PG8_STAGE(PG8_SA(0, 1), a2 + hstepA, voffA);
            PG8_WAIT_V(8); PG8_WAIT_L(0); PG8_BAR; PG8_MMA(0, 0, At, B0); PG8_MMA(0, 1, At, B1); PG8_BAR; PG8_SCHED;
            PG8_LDA(At, 1, 1); PG8_STAGE(PG8_SB(1, 0), b3, voffB); PG8_STAGE(PG8_SB(1, 1), b3 + hstepB, voffB); PG8_STAGE(PG8_SA(1, 0), a3, voffA);
            PG8_WAIT_V(8); PG8_WAIT_L(0); PG8_BAR; PG8_MMA(1, 0, At, B0); PG8_MMA(1, 1, At, B1); PG8_BAR; PG8_SCHED;
        }
        if (wr == 0) PG8_BAR;
        E(acc, cur, wr, wc, fr, fq);
        if (!has_next) break;
#pragma unroll
        for (int a = 0; a < 2; ++a)
#pragma unroll
            for (int b = 0; b < 2; ++b)
#pragma unroll
                for (int m = 0; m < 4; ++m)
#pragma unroll
                    for (int n = 0; n < 2; ++n) acc[a][b][m][n] = (f32x4){0.f, 0.f, 0.f, 0.f};
        cur = nxt; cA = nA; cB = nB; ++ui;
        if (wr == 1) PG8_BAR;
    }
    PG8_WAIT_V(0);
    PG8_BAR;
#undef PG8_SA
#undef PG8_SB
#undef PG8_STAGE
#undef PG8_LDA
#undef PG8_LDB
#undef PG8_MMA
#undef PG8_WAIT_V
#undef PG8_WAIT_L
#undef PG8_BAR
#undef PG8_SCHED
}
}

#define SCHED_FENCE() do { asm volatile("" ::: "memory"); __builtin_amdgcn_sched_barrier(0); } while (0)
#ifdef USE_SHFL
#define ROT_PREV(x) __shfl((x), lprev)
#define ROT_NEXT(x) __shfl((x), lnext)
#else
#define ROT_PREV(x) __int_as_float(__builtin_amdgcn_mov_dpp(__float_as_int(x), 0x121, 0xf, 0xf, true))
#define ROT_NEXT(x) __int_as_float(__builtin_amdgcn_mov_dpp(__float_as_int(x), 0x12F, 0xf, 0xf, true))
#endif
enum { EM_PROJ0 = 0, EM_QKV1 = 1, EM_RES = 2, EM_UP = 3 };
struct Epi {
    int mode;
    const float* ss;
    const float* bias0; int nb0;
    const float* bias1;
    bf16_t *q, *k, *r, *vt; float* t; const float* rope;
    const float *xs_c, *xs_x; float *xd_c, *xd_x; const float *gate_c, *gate_x, *gs_c, *gs_x; float* ss_out; bf16_t* act0;
    bf16_t* xrb; int src_f32, dst_f32;
    const float *conv, *convb; bf16_t* g;

    DI void operator()(f32x4 (&acc)[2][2][4][2], const pg8::Unit& u, int wr, int wc, int fr, int fq) const {
        const int colt = 32 * wc + 8 * fq;
#ifndef NO_RES
        if (mode == EM_RES) {
            const int path = (u.pm == 0);
            const float* xs = path ? xs_c : xs_x; float* xd = path ? xd_c : xd_x; const float* gate = path ? gate_c : gate_x; const float* gs = path ? gs_c : gs_x;
            const int rowoff = path ? 0 : 256;
            f32x4 gv[2][2], sv[2][2];
#pragma unroll
            for (int bj = 0; bj < 2; ++bj)
#pragma unroll
                for (int n = 0; n < 2; ++n) { const int c = u.pn * 256 + 64 * wc + 32 * bj + 8 * fq + 4 * n; gv[bj][n] = *(const f32x4*)(gate + c); sv[bj][n] = gs ? *(const f32x4*)(gs + c) : (f32x4){0.f, 0.f, 0.f, 0.f}; }
#pragma unroll
            for (int ai = 0; ai < 2; ++ai)
#pragma unroll
                for (int m = 0; m < 4; ++m) {
                    const int row = u.pm * 256 + ai * 128 + wr * 64 + m * 16 + fr; const size_t lo = (size_t)(row - rowoff) * D;
                    float ssum = 0.f;
#pragma unroll
                    for (int bj = 0; bj < 2; ++bj) {
                        const int c = u.pn * 256 + 64 * wc + 32 * bj + 8 * fq;
                        f32x4 x0, x1;
                        if (src_f32) { x0 = *(const f32x4*)(xs + lo + c); x1 = *(const f32x4*)(xs + lo + c + 4); }
                        else { const u32x4 rv = __builtin_nontemporal_load((const u32x4*)(xrb + (size_t)row * D + c)); x0 = (f32x4){bflo(rv.x), bfhi(rv.x), bflo(rv.y), bfhi(rv.y)}; x1 = (f32x4){bflo(rv.z), bfhi(rv.z), bflo(rv.w), bfhi(rv.w)}; }
                        const f32x4 y0 = x0 + gv[bj][0] * acc[ai][bj][m][0], y1 = x1 + gv[bj][1] * acc[ai][bj][m][1];
                        if (dst_f32) { *(f32x4*)(xd + lo + c) = y0; *(f32x4*)(xd + lo + c + 4) = y1; }
                        else { u32x4 wv; wv.x = pk2(y0[0], y0[1]); wv.y = pk2(y0[2], y0[3]); wv.z = pk2(y1[0], y1[1]); wv.w = pk2(y1[2], y1[3]); *(u32x4*)(xrb + (size_t)row * D + c) = wv; }
                        ssum += (y0[0] * y0[0] + y0[1] * y0[1]) + (y0[2] * y0[2] + y0[3] * y0[3]) + (y1[0] * y1[0] + y1[1] * y1[1]) + (y1[2] * y1[2] + y1[3] * y1[3]);
                        if (gs) { const f32x4 a0 = y0 * sv[bj][0], a1 = y1 * sv[bj][1]; u32x4 w; w.x = pk2(a0[0], a0[1]); w.y = pk2(a0[2], a0[3]); w.z = pk2(a1[0], a1[1]); w.w = pk2(a1[2], a1[3]);
                            *(u32x4*)(act0 + (size_t)row * D + c) = w; }
                    }
                    ssum += __shfl_xor(ssum, 16); ssum += __shfl_xor(ssum, 32);
                    if (fq == 0) atomicAdd(ss_out + row, ssum);
                }
            return;
        }
#endif
#ifndef NO_UP
        if (mode == EM_UP) {
            const int path = (u.pm < 2);
            {
                f32x4 bv[2][2]; float rsv[2][4];
#pragma unroll
                for (int bj = 0; bj < 2; ++bj)
#pragma unroll
                    for (int n = 0; n < 2; ++n) bv[bj][n] = *(const f32x4*)(bias0 + path * nb0 + u.pn * 256 + bj * 128 + colt + 4 * n);
#pragma unroll
                for (int ai = 0; ai < 2; ++ai)
#pragma unroll
                    for (int m = 0; m < 4; ++m) { const int grow = u.base + 62 * (2 * ai + wr) - 1 + 4 * fr + m; const int gcl = grow < 0 ? 0 : (grow >= MT ? MT - 1 : grow); rsv[ai][m] = ss[gcl]; }
#pragma unroll
                for (int ai = 0; ai < 2; ++ai)
#pragma unroll
                    for (int m = 0; m < 4; ++m) {
                        const int grow = u.base + 62 * (2 * ai + wr) - 1 + 4 * fr + m; const bool valid = grow >= u.lo && grow < u.hi;
                        const float rs = __builtin_amdgcn_rsqf(rsv[ai][m] * (1.f / D) + EPS);
#pragma unroll
                        for (int bj = 0; bj < 2; ++bj)
#pragma unroll
                            for (int n = 0; n < 2; ++n) { f32x4 v = acc[ai][bj][m][n] * rs + bv[bj][n]; if (!valid) v = (f32x4){0.f, 0.f, 0.f, 0.f}; acc[ai][bj][m][n] = v; }
                    }
            }
            SCHED_FENCE();
#pragma unroll
            for (int bj = 0; bj < 2; ++bj) {
                f32x4 cw[2][4];
#pragma unroll
                for (int n = 0; n < 2; ++n) { const int oc = (bj ? DFF : 0) + u.pn * 128 + colt + 4 * n;
                    cw[n][0] = *(const f32x4*)(conv + oc); cw[n][1] = *(const f32x4*)(conv + NUP + oc); cw[n][2] = *(const f32x4*)(conv + 2 * NUP + oc); cw[n][3] = *(const f32x4*)(convb + oc); }
#pragma unroll
                for (int ai = 0; ai < 2; ++ai)
#pragma unroll
                    for (int n = 0; n < 2; ++n) {
                        f32x4 tmp[4];
                        asm volatile("" : "+v"(acc[ai][bj][0][n]), "+v"(acc[ai][bj][1][n]), "+v"(acc[ai][bj][2][n]), "+v"(acc[ai][bj][3][n]));
#pragma unroll
                        for (int m = 0; m < 4; ++m) {
                            f32x4 pv, nv;
                            if (m > 0) pv = acc[ai][bj][m - 1][n];
                            else {
#pragma unroll
                                for (int j = 0; j < 4; ++j) pv[j] = __int_as_float(__builtin_amdgcn_mov_dpp(__float_as_int(acc[ai][bj][3][n][j]), 0x111, 0xf, 0xf, true)); }
                            if (m < 3) nv = acc[ai][bj][m + 1][n];
                            else {
#pragma unroll
                                for (int j = 0; j < 4; ++j) nv[j] = __int_as_float(__builtin_amdgcn_mov_dpp(__float_as_int(acc[ai][bj][0][n][j]), 0x101, 0xf, 0xf, true)); }
                            tmp[m] = cw[n][0] * pv + cw[n][1] * acc[ai][bj][m][n] + cw[n][2] * nv + cw[n][3];
                        }
#pragma unroll
                        for (int m = 0; m < 4; ++m) acc[ai][bj][m][n] = tmp[m];
                        asm volatile("" : "+v"(acc[ai][bj][0][n]), "+v"(acc[ai][bj][1][n]), "+v"(acc[ai][bj][2][n]), "+v"(acc[ai][bj][3][n]));
                    }
                SCHED_FENCE();
            }
#pragma unroll
            for (int ai = 0; ai < 2; ++ai) {
                const int bb = u.base + 62 * (2 * ai + wr) - 1;
#pragma unroll
                for (int m = 0; m < 4; ++m) {
                    const int lr = 4 * fr + m, orow = bb + lr;
                    if (lr >= 1 && lr <= 62 && orow >= u.lo && orow < u.hi) {
                        f32x4 g0, g1;
#pragma unroll
                        for (int j = 0; j < 4; ++j) { g0[j] = silu_f(acc[ai][0][m][0][j]) * acc[ai][1][m][0][j]; g1[j] = silu_f(acc[ai][0][m][1][j]) * acc[ai][1][m][1][j]; }
                        u32x4 w; w.x = pk2(g0[0], g0[1]); w.y = pk2(g0[2], g0[3]); w.z = pk2(g1[0], g1[1]); w.w = pk2(g1[2], g1[3]);
                        *(u32x4*)(g + (size_t)orow * DFF + u.pn * 128 + colt) = w;
                    }
                    SCHED_FENCE();
                }
            }
            return;
        }
#endif
#ifndef NO_PROJ
        if (u.kind == 1) {
            const int path = (u.pn == 0);
            f32x4 rs[2][2];
#pragma unroll
            for (int bj = 0; bj < 2; ++bj)
#pragma unroll
                for (int n = 0; n < 2; ++n) { const f32x4 s4 = *(const f32x4*)(ss + u.pn * 256 + bj * 128 + colt + 4 * n);
#pragma unroll
                    for (int j = 0; j < 4; ++j) rs[bj][n][j] = __builtin_amdgcn_rsqf(s4[j] * (1.f / D) + EPS); }
#pragma unroll
            for (int ai = 0; ai < 2; ++ai)
#pragma unroll
                for (int m = 0; m < 4; ++m) {
                    const int row = u.pm * 256 + ai * 128 + wr * 64 + m * 16 + fr; const float b = bias1[path * 1024 + row];
#pragma unroll
                    for (int bj = 0; bj < 2; ++bj) {
                        const f32x4 v0 = acc[ai][bj][m][0] * rs[bj][0] + b, v1 = acc[ai][bj][m][1] * rs[bj][1] + b;
                        if (mode == EM_QKV1) {
                            const int gb = u.pn * 256 + bj * 128 + 32 * wc + 16 * (fq >> 1) + 4 * (fq & 1);
                            *(u32x2*)(vt + (size_t)row * MT + gb) = (u32x2){pk2(v0[0], v0[1]), pk2(v0[2], v0[3])};
                            *(u32x2*)(vt + (size_t)row * MT + gb + 8) = (u32x2){pk2(v1[0], v1[1]), pk2(v1[2], v1[3])};
                        } else {
                        u32x4 w; w.x = pk2(v0[0], v0[1]); w.y = pk2(v0[2], v0[3]); w.z = pk2(v1[0], v1[1]); w.w = pk2(v1[2], v1[3]);
                        *(u32x4*)(vt + (size_t)row * MT + u.pn * 256 + bj * 128 + colt) = w;
                        }
                    }
                }
            return;
        }
        {
            const int path = (u.pm == 0);
            f32x4 bv[2][2];
#pragma unroll
            for (int bj = 0; bj < 2; ++bj)
#pragma unroll
                for (int n = 0; n < 2; ++n) bv[bj][n] = *(const f32x4*)(bias0 + path * nb0 + u.pn * 256 + bj * 128 + colt + 4 * n);
#pragma unroll
            for (int ai = 0; ai < 2; ++ai)
#pragma unroll
                for (int m = 0; m < 4; ++m) {
                    const int row = u.pm * 256 + ai * 128 + wr * 64 + m * 16 + fr;
                    const float rs = __builtin_amdgcn_rsqf(ss[row] * (1.f / D) + EPS);
#pragma unroll
                    for (int bj = 0; bj < 2; ++bj) {
                        f32x4 v0 = acc[ai][bj][m][0] * rs + bv[bj][0], v1 = acc[ai][bj][m][1] * rs + bv[bj][1];
                        const int gc = u.pn * 256 + bj * 128 + colt;
                        if (mode == EM_PROJ0) {
                            if (u.pn == 8) { if (bj == 0 && wc == 0) { *(f32x4*)(t + (size_t)row * 32 + colt) = v0; *(f32x4*)(t + (size_t)row * 32 + colt + 4) = v1; } continue; }
                            bf16_t* dst;
                            if (u.pn < 2) { v0 = v0 * 0.08838834764831845f; v1 = v1 * 0.08838834764831845f; dst = q + (size_t)row * 512 + gc; }
                            else if (u.pn < 4) dst = k + (size_t)row * 512 + (gc - 512);
                            else {
#pragma unroll
                                for (int j = 0; j < 4; ++j) { v0[j] = silu_f(v0[j]); v1[j] = silu_f(v1[j]); }
                                dst = r + (size_t)row * 1024 + (gc - 1024); }
                            u32x4 w; w.x = pk2(v0[0], v0[1]); w.y = pk2(v0[2], v0[3]); w.z = pk2(v1[0], v1[1]); w.w = pk2(v1[2], v1[3]);
                            *(u32x4*)dst = w;
                        } else {
                            if (row >= 256) {
                                const int tp = row - 256, pos = (wc & 1) ? (tp & 63) : (tp >> 6);
                                const f32x4 cs0 = *(const f32x4*)(rope + (pos * 16 + 4 * fq) * 2), cs1 = *(const f32x4*)(rope + (pos * 16 + 4 * fq + 2) * 2);
                                f32x4 w0, w1;
                                w0[0] = v0[0] * cs0[0] - v0[1] * cs0[1]; w0[1] = v0[1] * cs0[0] + v0[0] * cs0[1];
                                w0[2] = v0[2] * cs0[2] - v0[3] * cs0[3]; w0[3] = v0[3] * cs0[2] + v0[2] * cs0[3];
                                w1[0] = v1[0] * cs1[0] - v1[1] * cs1[1]; w1[1] = v1[1] * cs1[0] + v1[0] * cs1[1];
                                w1[2] = v1[2] * cs1[2] - v1[3] * cs1[3]; w1[3] = v1[3] * cs1[2] + v1[2] * cs1[3];
                                v0 = w0; v1 = w1;
                            }
                            bf16_t* dst;
                            if (u.pn < 4) { v0 = v0 * QSCALE1; v1 = v1 * QSCALE1; dst = q + (size_t)row * 1024 + gc; }
                            else dst = k + (size_t)row * 1024 + (gc - 1024);
                            u32x4 w; w.x = pk2(v0[0], v0[1]); w.y = pk2(v0[2], v0[3]); w.z = pk2(v1[0], v1[1]); w.w = pk2(v1[2], v1[3]);
                            *(u32x4*)dst = w;
                        }
                    }
                }
        }
#endif
#ifdef TRIVIAL_EPI
        for (int ai = 0; ai < 2; ++ai) for (int bj = 0; bj < 2; ++bj) for (int m = 0; m < 4; ++m) for (int n = 0; n < 2; ++n) *(f32x4*)(xd_x + (size_t)(u.pm * 256 + ai * 128 + wr * 64 + m * 16 + fr) * 1024 + u.pn * 256 + bj * 128 + colt + 4 * n) = acc[ai][bj][m][n];
#endif
    }
};

DI int map_src_col(int map, int j) {
    if (map == 1) { const int t = j >> 8, w = j & 255; return w < 128 ? 128 * t + w : DFF + 128 * t + (w - 128); }
    if (map == 2) { const int p = j & 63, a = p >> 5, rem = p & 31, f = rem >> 1, hh = rem & 1; return (j & ~63) + a * 32 + hh * 16 + f; }
    return j;
}
DI void transpose_item(const Piece& P, LAS float* scr, int item, int lane) {
    const int nblk = P.nrows / 32, kb = item / nblk, nb = item % nblk, k0 = 64 * kb, n0 = 32 * nb;
    const int sc = map_src_col(P.map, n0 + (lane & 31));
#pragma unroll 32
    for (int i = 0; i < 32; ++i) { const int kk = 2 * i + (lane >> 5); scr[kk * 33 + (lane & 31)] = __builtin_nontemporal_load(P.src + (size_t)(k0 + kk) * P.Nsrc + sc); }
    asm volatile("s_waitcnt lgkmcnt(0)" ::: "memory");
    const int c = lane & 7;
#pragma unroll
    for (int j = 0; j < 4; ++j) { const int n = (lane >> 3) + 8 * j; const LAS float* s = scr + (8 * c) * 33 + n;
        u32x4 o; o.x = pk2(s[0 * 33], s[1 * 33]); o.y = pk2(s[2 * 33], s[3 * 33]); o.z = pk2(s[4 * 33], s[5 * 33]); o.w = pk2(s[6 * 33], s[7 * 33]);
        *(u32x4*)(P.dst + (size_t)(n0 + n) * P.K + k0 + 8 * c) = o; }
    asm volatile("s_waitcnt lgkmcnt(0)" ::: "memory");
}

DI void phase_p0a(const Params& P, LAS unsigned char* lds, float* misc) {
    int tid_ = threadIdx.x; asm volatile("" : "+v"(tid_)); const int tid = tid_, lane = tid & 63, w = tid >> 6, G = gridDim.x;
    const int gtid = blockIdx.x * 512 + tid, NT = G * 512;
    {
        LAS float* red = (LAS float*)lds;
        const float* c = P.in[1]; const float* cc = P.in[3];
        for (int it = blockIdx.x; it < 192; it += G) {
            const int l = it / 96, n = (it % 96) * 64 + lane;
            const float* W = P.in[4] + (size_t)l * D * 6144;
            float ax = 0.f, ac = 0.f;
#pragma unroll 32
            for (int kk = 0; kk < 128; ++kk) { const int k = w * 128 + kk; const float wv = __builtin_nontemporal_load(W + (size_t)k * 6144 + n); ax += silu_f(c[k]) * wv; ac += silu_f(cc[k]) * wv; }
            __syncthreads();
            red[(w * 64 + lane) * 2] = ax; red[(w * 64 + lane) * 2 + 1] = ac;
            __syncthreads();
            if (w == 0) { float sx = 0.f, sc = 0.f;
#pragma unroll
                for (int i = 0; i < 8; ++i) { sx += red[(i * 64 + lane) * 2]; sc += red[(i * 64 + lane) * 2 + 1]; }
                const float b = P.in[5][l * 6144 + n];
                misc[OFF_MOD + (l * 2 + 0) * 6144 + n] = sx + b; misc[OFF_MOD + (l * 2 + 1) * 6144 + n] = sc + b; }
        }
        __syncthreads();
    }
    {
        LAS float* scr = (LAS float*)(lds + w * 16384);
        const int gw = blockIdx.x * 8 + w, NGW = G * 8;
        int total = 0;
#pragma unroll 1
        for (int p = 0; p < 13; ++p) total += (P.pc[p].K / 64) * (P.pc[p].nrows / 32);
        for (int it = gw; it < total; it += NGW) {
            int r = it, p = 0;
#pragma unroll 1
            for (; p < 12; ++p) { const int cnt = (P.pc[p].K / 64) * (P.pc[p].nrows / 32); if (r < cnt) break; r -= cnt; }
            transpose_item(P.pc[p], scr, r, lane);
        }
    }
    {
        bf16_t* wp0 = (bf16_t*)(P.ws + W_P0);
        const float* wg1 = P.in[12];
        for (int e = gtid; e < 256 * 1024; e += NT) { const int row = e >> 10, k = e & 1023; float v = 0.f; if (row < 32) v = wg1[(row >> 4) * 16384 + k * 16 + (row & 15)];
            wp0[(size_t)(2048 + row) * 1024 + k] = (bf16_t)(pk2(v, 0.f) & 0xffff); }
    }
    if (gtid < 4096) { const int pos = gtid >> 4, f = gtid & 15; const float inv = powf(10000.f, -(float)f / 16.f); const float ang = (float)pos * inv;
        misc[OFF_ROPE + gtid * 2] = cosf(ang); misc[OFF_ROPE + gtid * 2 + 1] = sinf(ang); }
    if (gtid == 0) { float s1 = 0.f, s2 = 0.f; for (int i = 0; i < 64; ++i) { s1 += P.in[20][i] * P.in[21][i]; s2 += P.in[22][i] * P.in[23][i]; }
        misc[OFF_LAM] = expf(s1) - expf(s2) + LAMBDA_INIT; }
    for (int e = gtid; e < 4 * MT; e += NT) misc[OFF_SS + MT + e] = 0.f;
}

DI void phase_p0b(const Params& P, float* misc) {
    int tid_ = threadIdx.x; asm volatile("" : "+v"(tid_)); const int tid = tid_, lane = tid & 63, w = tid >> 6, G = gridDim.x;
    const int gtid = blockIdx.x * 512 + tid, NT = G * 512, gw = blockIdx.x * 8 + w, NGW = G * 8;
    for (int e = gtid; e < 8192; e += NT) { const int c = e & 1023, path = (e >> 10) & 1, s = (e >> 11) & 1, l = e >> 12;
        const float nv = (s ? P.in[7] : P.in[6])[l * D + c]; misc[OFF_GS + e] = nv * (1.f + misc[OFF_MOD + (l * 2 + path) * 6144 + (s ? 4 : 1) * 1024 + c]); }
    bf16_t* act0 = (bf16_t*)(P.ws + WS_ACT0 + ACT0_PAD);
    for (int row = gw; row < MT; row += NGW) {
        const int path = row < 256; const float* src = path ? P.in[2] + (size_t)row * D : P.in[0] + (size_t)(row - 256) * D;
        const float* sc = misc + OFF_MOD + (0 * 2 + path) * 6144 + 1024; const float* nm = P.in[6];
        float s = 0.f;
#pragma unroll
        for (int j = 0; j < 4; ++j) { const int c = 4 * lane + 256 * j; const f32x4 v = __builtin_nontemporal_load((const f32x4*)(src + c)); const f32x4 g4 = *(const f32x4*)(nm + c) * (*(const f32x4*)(sc + c) + 1.f);
            s += (v[0] * v[0] + v[1] * v[1]) + (v[2] * v[2] + v[3] * v[3]); const f32x4 a = v * g4; u32x2 o; o.x = pk2(a[0], a[1]); o.y = pk2(a[2], a[3]); *(u32x2*)(act0 + (size_t)row * D + c) = o;
            u32x2 xr; xr.x = pk2(v[0], v[1]); xr.y = pk2(v[2], v[3]); *(u32x2*)((bf16_t*)(P.ws + WS_XR) + (size_t)row * D + c) = xr; }
        s = wave_sum(s);
        if (lane == 0) misc[OFF_SS + row] = s;
    }
    for (int it = gw; it < 17664; it += NGW) {
        int j = it; const bf16_t* Wt; int boff, nb, l, sh;
        if (j < 2304) { Wt = (const bf16_t*)(P.ws + W_P0); boff = B_P0; nb = 2304; l = 0; sh = 0; }
        else if ((j -= 2304) < 1024) { Wt = (const bf16_t*)(P.ws + W_V0); boff = B_V0; nb = 1024; l = 0; sh = 0; }
        else if ((j -= 1024) < 5632) { Wt = (const bf16_t*)(P.ws + W_UP0); boff = B_UP0; nb = 5632; l = 0; sh = 3; }
        else if ((j -= 5632) < 2048) { Wt = (const bf16_t*)(P.ws + W_QK1); boff = B_QK1; nb = 2048; l = 1; sh = 0; }
        else if ((j -= 2048) < 1024) { Wt = (const bf16_t*)(P.ws + W_V1); boff = B_V1; nb = 1024; l = 1; sh = 0; }
        else { j -= 1024; Wt = (const bf16_t*)(P.ws + W_UP1); boff = B_UP1; nb = 5632; l = 1; sh = 3; }
        const float* s0 = misc + OFF_MOD + (l * 2 + 0) * 6144 + sh * 1024; const float* s1 = misc + OFF_MOD + (l * 2 + 1) * 6144 + sh * 1024;
        float a0 = 0.f, a1 = 0.f;
#pragma unroll
        for (int i = 0; i < 2; ++i) { const int k = 8 * lane + 512 * i; const u32x4 wv = *(const u32x4*)(Wt + (size_t)j * 1024 + k);
            const f32x4 x0 = *(const f32x4*)(s0 + k), x1 = *(const f32x4*)(s0 + k + 4), y0 = *(const f32x4*)(s1 + k), y1 = *(const f32x4*)(s1 + k + 4);
            const float w0 = bflo(wv.x), w1 = bfhi(wv.x), w2 = bflo(wv.y), w3 = bfhi(wv.y), w4 = bflo(wv.z), w5 = bfhi(wv.z), w6 = bflo(wv.w), w7 = bfhi(wv.w);
            a0 += x0[0] * w0 + x0[1] * w1 + x0[2] * w2 + x0[3] * w3 + x1[0] * w4 + x1[1] * w5 + x1[2] * w6 + x1[3] * w7;
            a1 += y0[0] * w0 + y0[1] * w1 + y0[2] * w2 + y0[3] * w3 + y1[0] * w4 + y1[1] * w5 + y1[2] * w6 + y1[3] * w7; }
        a0 = wave_sum(a0); a1 = wave_sum(a1);
        if (lane == 0) { misc[OFF_BIAS + boff + j] = a0; misc[OFF_BIAS + boff + nb + j] = a1; }
    }
}

constexpr int GL_LQ = 0, GL_LK = 17408, GL_LKT = 34816, GL_LSC = 53248, GL_LA = 62464, GL_LGT = 62976, GL_LT = 65024 + 2048, GL_LO = 0;
static_assert(GL_LGT >= 62464 + 512 && GL_LT >= 66560, "gla lds");
DI float logsig(float x) { return fminf(x, 0.f) - __logf(1.f + __expf(-fabsf(x))); }

DI void gla_sweep(const Params& P, LAS unsigned char* lds, float* misc, int seg, int h, int d, int outmode) {
    int tid_ = threadIdx.x; asm volatile("" : "+v"(tid_)); const int tid = tid_, lane = tid & 63, w = __builtin_amdgcn_readfirstlane(tid >> 6), l31 = lane & 31, hh = lane >> 5, l15 = lane & 15, l4 = lane >> 4;
    const int p0 = (260 * seg) / NSEG, nch = (260 * (seg + 1)) / NSEG - p0;
    const int oidx = seg;
    const int dk = tid & 127, tg = tid >> 7;
    const bf16_t* Q0 = (const bf16_t*)(P.ws + R_Q0); const bf16_t* K0 = (const bf16_t*)(P.ws + R_K0); const bf16_t* R0 = (const bf16_t*)(P.ws + R_R0);
    const bf16_t* Vt = (const bf16_t*)(P.ws + R_VT); const float* T0 = (const float*)(P.ws + R_T0);
    bf16_t* odst = d == 0 ? (bf16_t*)(P.ws + WS_ACT1) : (bf16_t*)P.out;
    float* SB = (float*)(P.ws + WS_SB) + (size_t)(oidx * 8 + h * 2 + d) * 32768;
    LAS bf16_t* LQ = (LAS bf16_t*)(lds + GL_LQ); LAS bf16_t* LK = (LAS bf16_t*)(lds + GL_LK); LAS bf16_t* LKT = (LAS bf16_t*)(lds + GL_LKT); LAS bf16_t* LSC = (LAS bf16_t*)(lds + GL_LSC);
    LAS float* LA = (LAS float*)(lds + GL_LA); LAS float* LGT = (LAS float*)(lds + GL_LGT); LAS float* LT = (LAS float*)(lds + GL_LT); LAS float* LO = (LAS float*)(lds + GL_LO);
    float w2[16];
#pragma unroll
    for (int r = 0; r < 16; ++r) w2[r] = P.in[13][(d * 16 + r) * 512 + h * 128 + dk];
    const float bgv = P.in[14][d * 512 + h * 128 + dk];
    f32x16 S[4];
#pragma unroll
    for (int jt = 0; jt < 4; ++jt)
#pragma unroll
        for (int r = 0; r < 16; ++r) S[jt][r] = outmode == 0 ? 0.f : __builtin_nontemporal_load(SB + (32 * jt + crow(r, hh)) * 256 + 32 * w + l31);
    float logA = 0.f;
    f32x4 tpre = {0.f, 0.f, 0.f, 0.f};
    { const int c_ = d == 0 ? p0 : (p0 < 4 ? 3 - p0 : 263 - p0); if (tid < 256) tpre = *(const f32x4*)(T0 + (size_t)(64 * c_ + (tid >> 2)) * 32 + 16 * d + 4 * (tid & 3)); }
    for (int ci = 0; ci < nch; ++ci) {
        const int pp = p0 + ci; const int c = d == 0 ? pp : (pp < 4 ? 3 - pp : 263 - pp); const int tok0 = 64 * c;
        bf16x8 vf[4];
#pragma unroll
        for (int kk = 0; kk < 4; ++kk) vf[kk] = *(const bf16x8*)(Vt + (size_t)(h * 256 + 32 * w + l31) * MT + tok0 + 16 * kk + 8 * hh);
        unsigned kraw[16], qraw[16];
#pragma unroll
        for (int i = 0; i < 16; ++i) { const size_t o_ = (size_t)(tok0 + 16 * tg + i) * 512 + h * 128 + dk; kraw[i] = K0[o_]; qraw[i] = outmode ? (unsigned)Q0[o_] : 0u; }
        __syncthreads();
        if (tid < 256) *(LAS f32x4*)(LT + (tid >> 2) * 16 + 4 * (tid & 3)) = tpre;
        __syncthreads();
        if (ci + 1 < nch && tid < 256) { const int pn = pp + 1; const int cn = d == 0 ? pn : (pn < 4 ? 3 - pn : 263 - pn); tpre = *(const f32x4*)(T0 + (size_t)(64 * cn + (tid >> 2)) * 32 + 16 * d + 4 * (tid & 3)); }
        float b[16];
#pragma unroll
        for (int i = 0; i < 16; ++i) { float pre = bgv;
#pragma unroll
            for (int r4 = 0; r4 < 4; ++r4) { const f32x4 tv = *(const LAS f32x4*)(LT + (16 * tg + i) * 16 + 4 * r4); pre += tv[0] * w2[4 * r4] + tv[1] * w2[4 * r4 + 1] + tv[2] * w2[4 * r4 + 2] + tv[3] * w2[4 * r4 + 3]; }
            b[i] = logsig(pre) * (1.f / 16.f); }
        if (d == 0) {
#pragma unroll
            for (int i = 1; i < 16; ++i) b[i] += b[i - 1];
            LGT[tg * 128 + dk] = b[15];
        } else {
#pragma unroll
            for (int i = 14; i >= 0; --i) b[i] += b[i + 1];
            LGT[tg * 128 + dk] = b[0];
        }
        __syncthreads();
        const float g0 = LGT[dk], g1 = LGT[128 + dk], g2 = LGT[256 + dk], g3 = LGT[384 + dk];
        const float btot = (g0 + g1) + (g2 + g3);
        float off;
        if (d == 0) off = (tg > 0 ? g0 : 0.f) + (tg > 1 ? g1 : 0.f) + (tg > 2 ? g2 : 0.f);
        else off = (tg < 1 ? g1 : 0.f) + (tg < 2 ? g2 : 0.f) + (tg < 3 ? g3 : 0.f);
        if (tg == 0) LA[dk] = __expf(btot);
        logA += btot;
        unsigned ktp[8];
#pragma unroll
        for (int i = 0; i < 16; i += 2) {
            const float b0 = b[i] + off, b1 = b[i + 1] + off;
            const float k0 = __uint_as_float(kraw[i] << 16), k1 = __uint_as_float(kraw[i + 1] << 16);
            ktp[i >> 1] = pk2(k0 * __expf(btot - b0), k1 * __expf(btot - b1));
            if (outmode) {
                const float q0 = __uint_as_float(qraw[i] << 16), q1 = __uint_as_float(qraw[i + 1] << 16);
                LQ[(16 * tg + i) * 136 + dk] = (bf16_t)(pk2(q0 * __expf(b0), 0.f) & 0xffff); LQ[(16 * tg + i + 1) * 136 + dk] = (bf16_t)(pk2(q1 * __expf(b1), 0.f) & 0xffff);
                LK[(16 * tg + i) * 136 + dk] = (bf16_t)(pk2(k0 * __expf(-b0), 0.f) & 0xffff); LK[(16 * tg + i + 1) * 136 + dk] = (bf16_t)(pk2(k1 * __expf(-b1), 0.f) & 0xffff);
            }
        }
        *(LAS u32x4*)(LKT + dk * 72 + 16 * tg) = (u32x4){ktp[0], ktp[1], ktp[2], ktp[3]};
        *(LAS u32x4*)(LKT + dk * 72 + 16 * tg + 8) = (u32x4){ktp[4], ktp[5], ktp[6], ktp[7]};
        __syncthreads();
        f32x16 o[2];
        if (outmode) {
            const int ti = w >> 1;
#pragma unroll
            for (int sj = 0; sj < 2; ++sj) { const int si = 2 * (w & 1) + sj; f32x4 a4 = {0.f, 0.f, 0.f, 0.f};
#pragma unroll
                for (int kk = 0; kk < 4; ++kk) { const bf16x8 fa = *(const LAS bf16x8*)(LK + (16 * si + l15) * 136 + 32 * kk + 8 * l4), fb = *(const LAS bf16x8*)(LQ + (16 * ti + l15) * 136 + 32 * kk + 8 * l4);
                    a4 = __builtin_amdgcn_mfma_f32_16x16x32_bf16(fa, fb, a4, 0, 0, 0); }
                const int t = 16 * ti + l15, s0 = 16 * si + 4 * l4;
#pragma unroll
                for (int r = 0; r < 4; ++r) { const int s = s0 + r; const bool keep = d == 0 ? (s <= t) : (s >= t); if (!keep) a4[r] = 0.f; }
                *(LAS u32x2*)(LSC + t * 72 + s0) = (u32x2){pk2(a4[0], a4[1]), pk2(a4[2], a4[3])}; }
            __syncthreads();
#pragma unroll
            for (int tt = 0; tt < 2; ++tt) {
                f32x16 oo;
#pragma unroll
                for (int r = 0; r < 16; ++r) oo[r] = 0.f;
#pragma unroll
                for (int kk = 0; kk < 4; ++kk) { const bf16x8 fa = *(const LAS bf16x8*)(LSC + (32 * tt + l31) * 72 + 16 * kk + 8 * hh); oo = __builtin_amdgcn_mfma_f32_32x32x16_bf16(fa, vf[kk], oo, 0, 0, 0); }
#pragma unroll
                for (int jt = 0; jt < 4; ++jt)
#pragma unroll
                    for (int s2 = 0; s2 < 2; ++s2) {
                        const u32x4 pb = {pk2(S[jt][8 * s2], S[jt][8 * s2 + 1]), pk2(S[jt][8 * s2 + 2], S[jt][8 * s2 + 3]), pk2(S[jt][8 * s2 + 4], S[jt][8 * s2 + 5]), pk2(S[jt][8 * s2 + 6], S[jt][8 * s2 + 7])};
                        const u32x2 alo = *(const LAS u32x2*)(LQ + (32 * tt + l31) * 136 + 32 * jt + 16 * s2 + 4 * hh), ahi = *(const LAS u32x2*)(LQ + (32 * tt + l31) * 136 + 32 * jt + 16 * s2 + 8 + 4 * hh);
                        const u32x4 pa = {alo.x, alo.y, ahi.x, ahi.y};
                        oo = __builtin_amdgcn_mfma_f32_32x32x16_bf16(__builtin_bit_cast(bf16x8, pa), __builtin_bit_cast(bf16x8, pb), oo, 0, 0, 0);
                    }
                o[tt] = oo;
            }
        }
#pragma unroll
        for (int jt = 0; jt < 4; ++jt) {
#pragma unroll
            for (int r = 0; r < 16; ++r) S[jt][r] *= LA[32 * jt + crow(r, hh)];
#pragma unroll
            for (int kk = 0; kk < 4; ++kk) { const bf16x8 fa = *(const LAS bf16x8*)(LKT + (32 * jt + l31) * 72 + 16 * kk + 8 * hh); S[jt] = __builtin_amdgcn_mfma_f32_32x32x16_bf16(fa, vf[kk], S[jt], 0, 0, 0); }
        }
        if (outmode == 1) {
#pragma unroll
            for (int tt = 0; tt < 2; ++tt)
#pragma unroll
                for (int r = 0; r < 16; ++r) odst[(size_t)(tok0 + 32 * tt + crow(r, hh)) * D + h * 256 + 32 * w + l31] = (bf16_t)(pk2(o[tt][r], 0.f) & 0xffff);
        }
    }
    if (outmode == 0) {
#pragma unroll
        for (int jt = 0; jt < 4; ++jt)
#pragma unroll
            for (int r = 0; r < 16; ++r) SB[(32 * jt + crow(r, hh)) * 256 + 32 * w + l31] = S[jt][r];
        if (tg == 0) misc[OFF_ASEG + (oidx * 8 + h * 2 + d) * 128 + dk] = __expf(logA);
    }
    __syncthreads();
}

DI void phase_gla_readout(const Params& P) {
    int tid_ = threadIdx.x; asm volatile("" : "+v"(tid_)); const int lane = tid_ & 63, gw = blockIdx.x * 8 + (tid_ >> 6), NGW = gridDim.x * 8;
    bf16_t* act1 = (bf16_t*)(P.ws + WS_ACT1); const bf16_t* ob = (const bf16_t*)P.out; const bf16_t* R0 = (const bf16_t*)(P.ws + R_R0);
    const f32x4 gn = *(const f32x4*)(P.in[15] + 4 * lane);
    for (int it0 = gw; it0 < MT * 4; it0 += 4 * NGW) {
        u32x2 a[4], b[4], r[4]; size_t off[4];
#pragma unroll
        for (int j = 0; j < 4; ++j) { const int it = it0 + j * NGW; const int itc = it < MT * 4 ? it : it0; off[j] = (size_t)(itc >> 2) * D + (itc & 3) * 256 + 4 * lane;
            a[j] = __builtin_nontemporal_load((const u32x2*)(act1 + off[j])); b[j] = __builtin_nontemporal_load((const u32x2*)(ob + off[j])); r[j] = __builtin_nontemporal_load((const u32x2*)(R0 + off[j])); }
#pragma unroll
        for (int j = 0; j < 4; ++j) {
            const float o0 = bflo(a[j].x) + bflo(b[j].x), o1 = bfhi(a[j].x) + bfhi(b[j].x), o2 = bflo(a[j].y) + bflo(b[j].y), o3 = bfhi(a[j].y) + bfhi(b[j].y);
            const float sq = wave_sum((o0 * o0 + o1 * o1) + (o2 * o2 + o3 * o3));
            const float rstd = __builtin_amdgcn_rsqf(sq * (1.f / 256.f) + EPS);
            u32x2 w; w.x = pk2(o0 * rstd * gn[0] * bflo(r[j].x), o1 * rstd * gn[1] * bfhi(r[j].x)); w.y = pk2(o2 * rstd * gn[2] * bflo(r[j].y), o3 * rstd * gn[3] * bfhi(r[j].y));
            if (it0 + j * NGW < MT * 4) *(u32x2*)(act1 + off[j]) = w;
        }
    }
}

DI void phase_gla_combine(const Params& P, float* misc) {
    int tid_ = threadIdx.x; asm volatile("" : "+v"(tid_));
    const int gid = blockIdx.x * 512 + tid_;
    for (int e2 = gid; e2 < 131072; e2 += gridDim.x * 512) {
        const int e = 2 * e2, hd = e >> 15, idx = e & 32767, dk = idx >> 8;
        float* base = (float*)(P.ws + WS_SB) + (size_t)hd * 32768 + idx;
        f32x2 run = {0.f, 0.f};
#pragma unroll 11
        for (int o = 0; o < NSEG; ++o) { f32x2* p = (f32x2*)(base + (size_t)o * 8 * 32768); const f32x2 tmp = __builtin_nontemporal_load(p); *p = run; const float a = misc[OFF_ASEG + (o * 8 + hd) * 128 + dk]; run = run * a + tmp; }
    }
}

constexpr int AT_BUF = 36864, AT_V = 17408;
constexpr float AT_THR = 8.0f;
DI void attn_unit(const Params& P, LAS unsigned char* lds, const float* misc, int h, int qb) {
    int tid_ = threadIdx.x; asm volatile("" : "+v"(tid_)); const int tid = tid_, lane = tid & 63, w = __builtin_amdgcn_readfirstlane(tid >> 6), l31 = lane & 31, hh = lane >> 5;
    const int ns = w >> 2, qrow0 = 256 + qb * 128 + 32 * (w & 3);
    const bf16_t* Q1 = (const bf16_t*)(P.ws + R_Q1); const bf16_t* K1 = (const bf16_t*)(P.ws + R_K1); const bf16_t* Vt = (const bf16_t*)(P.ws + R_VT);
    bf16_t* act1 = (bf16_t*)(P.ws + WS_ACT1);
    bf16x8 qf[4];
#pragma unroll
    for (int kk = 0; kk < 4; ++kk) qf[kk] = *(const bf16x8*)(Q1 + (size_t)(qrow0 + l31) * D + h * 128 + ns * 64 + 16 * kk + 8 * hh);
    LAS unsigned char* qlds = lds + 3 * AT_BUF + w * 4096 + lane * 16;
#pragma unroll
    for (int kk = 0; kk < 4; ++kk) *(LAS bf16x8*)(qlds + kk * 1024) = qf[kk];
    f32x16 o[4];
#pragma unroll
    for (int jt = 0; jt < 4; ++jt)
#pragma unroll
        for (int r = 0; r < 16; ++r) o[jt][r] = 0.f;
    float mrun = 0.f, lsum = 0.f;
    const int krow = tid >> 4, kc = tid & 15, vrow = tid >> 2, vc = tid & 3;
    const unsigned koff = (unsigned)(krow * D + h * 128 + 8 * kc), voff = (unsigned)((h * 128 + vrow) * MT + 16 * vc);
    u32x4 kreg[2], vreg[2];
    constexpr int NT = MT / 64;
#define AT_LOAD(t) do { const bf16_t* kb_ = K1 + (size_t)(64 * (t)) * D; const bf16_t* vb_ = Vt + 64 * (t); kreg[0] = *(const u32x4*)(kb_ + koff); kreg[1] = *(const u32x4*)(kb_ + 32 * D + koff); \
        vreg[0] = *(const u32x4*)(vb_ + voff); vreg[1] = *(const u32x4*)(vb_ + 8 + voff); } while (0)
#define AT_STORE(b) do { *(LAS u32x4*)(lds + (b) * AT_BUF + krow * 272 + kc * 16) = kreg[0]; *(LAS u32x4*)(lds + (b) * AT_BUF + (krow + 32) * 272 + kc * 16) = kreg[1]; \
        *(LAS u32x4*)(lds + (b) * AT_BUF + AT_V + vrow * 144 + vc * 32) = vreg[0]; *(LAS u32x4*)(lds + (b) * AT_BUF + AT_V + vrow * 144 + vc * 32 + 16) = vreg[1]; } while (0)
#define AT_QK(dst, b) do { LAS unsigned char* kb_ = lds + (b) * AT_BUF; _Pragma("unroll") for (int kt = 0; kt < 2; ++kt) { f32x16 a_; _Pragma("unroll") for (int r = 0; r < 16; ++r) a_[r] = 0.f; \
        _Pragma("unroll") for (int kk = 0; kk < 4; ++kk) { const bf16x8 fa = *(const LAS bf16x8*)(kb_ + (32 * kt + l31) * 272 + (ns * 64 + 16 * kk + 8 * hh) * 2); a_ = __builtin_amdgcn_mfma_f32_32x32x16_bf16(fa, qf[kk], a_, 0, 0, 0); } \
        dst[kt] = a_; } } while (0)
    AT_LOAD(0); AT_STORE(0); AT_LOAD(1); AT_STORE(1);
    __syncthreads();
    f32x16 s[2], sn[2];
    AT_QK(s, 0);
    AT_LOAD(2);
    int bv = 0, bk = 1, bw = 2;
    const u32x4 ones4 = {0x3F803F80u, 0x3F803F80u, 0x3F803F80u, 0x3F803F80u};
    u32x4 nf = {0u, 0u, 0u, 0u};
#define AT_STEP(S, SN, t) do { \
        if ((t) + 2 < NT) AT_STORE(bw); \
        if ((t) + 3 < NT) AT_LOAD((t) + 3); \
        float mx = fmaxf(fmaxf(S[0][0], S[0][1]), S[0][2]); \
        _Pragma("unroll") for (int r = 3; r < 15; r += 2) mx = fmaxf(fmaxf(mx, S[0][r]), S[0][r + 1]); \
        mx = fmaxf(mx, S[0][15]); \
        _Pragma("unroll") for (int r = 0; r < 16; r += 2) mx = fmaxf(fmaxf(mx, S[1][r]), S[1][r + 1]); \
        mx = fmaxf(mx, __shfl_xor(mx, 32)); \
        if ((t) == 0 || __builtin_amdgcn_ballot_w64(mx > AT_THR) != 0ull) { \
            const float want = mrun + (((t) == 0 || mx > AT_THR) ? mx : 0.f); \
            const float nref = __uint_as_float((__float_as_uint(want) + 0x8000u) & 0xffff0000u);     \
            const float delta = nref - mrun; mrun = nref; \
            const float alpha = __builtin_amdgcn_exp2f(-delta); \
            _Pragma("unroll") for (int kt = 0; kt < 2; ++kt) _Pragma("unroll") for (int r = 0; r < 16; ++r) S[kt][r] -= delta; \
            _Pragma("unroll") for (int jt = 0; jt < 4; ++jt) _Pragma("unroll") for (int r = 0; r < 16; ++r) o[jt][r] *= alpha; \
            lsum *= alpha; \
            nf.x = hh == 0 ? (__float_as_uint(-mrun) >> 16) : 0u; \
        } \
        LAS unsigned char* kb = lds + bk * AT_BUF; LAS unsigned char* vb = lds + bv * AT_BUF + AT_V; \
        bf16x8 kf[4], vf0[4], qv[4]; \
        { LAS unsigned char* qa_ = qlds; asm volatile("" : "+v"(qa_)); _Pragma("unroll") for (int kk = 0; kk < 4; ++kk) qv[kk] = *(const LAS bf16x8*)(qa_ + kk * 1024); } \
        f32x16 zero16; \
        _Pragma("unroll") for (int r = 0; r < 16; ++r) zero16[r] = 0.f; \
        _Pragma("unroll") for (int i = 0; i < 4; ++i) kf[i] = *(const LAS bf16x8*)(kb + l31 * 272 + (ns * 64 + 16 * i + 8 * hh) * 2); \
        __builtin_amdgcn_sched_barrier(0); \
        SN[0] = __builtin_amdgcn_mfma_f32_32x32x16_bf16(__builtin_bit_cast(bf16x8, ones4), __builtin_bit_cast(bf16x8, nf), zero16, 0, 0, 0); \
        _Pragma("unroll") for (int kk = 0; kk < 4; ++kk) SN[0] = __builtin_amdgcn_mfma_f32_32x32x16_bf16(kf[kk], qv[kk], SN[0], 0, 0, 0); \
        _Pragma("unroll") for (int i = 0; i < 4; ++i) kf[i] = *(const LAS bf16x8*)(kb + (32 + l31) * 272 + (ns * 64 + 16 * i + 8 * hh) * 2); \
        SN[1] = __builtin_amdgcn_mfma_f32_32x32x16_bf16(__builtin_bit_cast(bf16x8, ones4), __builtin_bit_cast(bf16x8, nf), zero16, 0, 0, 0); \
        _Pragma("unroll") for (int kk = 0; kk < 4; ++kk) SN[1] = __builtin_amdgcn_mfma_f32_32x32x16_bf16(kf[kk], qv[kk], SN[1], 0, 0, 0); \
        _Pragma("unroll") for (int jt = 0; jt < 4; ++jt) vf0[jt] = *(const LAS bf16x8*)(vb + (32 * jt + l31) * 144 + 8 * hh * 2); \
        float ps0 = 0.f, ps1 = 0.f; \
        _Pragma("unroll") for (int kt = 0; kt < 2; ++kt) _Pragma("unroll") for (int r = 0; r < 16; r += 2) { const float p0 = __builtin_amdgcn_exp2f(S[kt][r]), p1 = __builtin_amdgcn_exp2f(S[kt][r + 1]); S[kt][r] = p0; S[kt][r + 1] = p1; ps0 += p0; ps1 += p1; } \
        lsum += ps0 + ps1; \
        __builtin_amdgcn_sched_barrier(0); \
        AT_PV(S, 0); AT_PV(S, 1); AT_PV(S, 2); AT_PV(S, 3); \
        { const int tmp = bv; bv = bk; bk = bw; bw = tmp; } \
        __syncthreads(); } while (0)
#define AT_PV(S, step) do { const int kt_ = (step) >> 1, s2_ = (step) & 1; \
            const u32x4 pb = {pk2(S[kt_][8 * s2_], S[kt_][8 * s2_ + 1]), pk2(S[kt_][8 * s2_ + 2], S[kt_][8 * s2_ + 3]), pk2(S[kt_][8 * s2_ + 4], S[kt_][8 * s2_ + 5]), pk2(S[kt_][8 * s2_ + 6], S[kt_][8 * s2_ + 7])}; \
            _Pragma("unroll") for (int jt = 0; jt < 4; ++jt) o[jt] = __builtin_amdgcn_mfma_f32_32x32x16_bf16(vf0[jt], __builtin_bit_cast(bf16x8, pb), o[jt], 0, 0, 0); \
            if ((step) < 3) { _Pragma("unroll") for (int jt = 0; jt < 4; ++jt) vf0[jt] = *(const LAS bf16x8*)(vb + (32 * jt + l31) * 144 + (16 * ((step) + 1) + 8 * hh) * 2); } \
            __builtin_amdgcn_sched_barrier(0); } while (0)
    static_assert(NT % 2 == 0, "ping-pong loop");
    for (int t = 0; t < NT; t += 2) { AT_STEP(s, sn, t); AT_STEP(sn, s, t + 1); }
#undef AT_STEP
#undef AT_PV
#undef AT_LOAD
#undef AT_STORE
#undef AT_QK
    const float ltot = lsum + __shfl_xor(lsum, 32);
    const float inv = 1.f / ltot;
    LAS float* XB = (LAS float*)lds;
    if (ns == 1) {
        const float f = inv * misc[OFF_LAM];
#pragma unroll
        for (int jt = 0; jt < 4; ++jt)
#pragma unroll
            for (int r = 0; r < 16; ++r) XB[(((w & 3) * 4 + jt) * 16 + r) * 64 + lane] = o[jt][r] * f;
    }
    __syncthreads();
    if (ns == 0) {
        float sq = 0.f;
#pragma unroll
        for (int jt = 0; jt < 4; ++jt)
#pragma unroll
            for (int r = 0; r < 16; ++r) { const float v = o[jt][r] * inv - XB[(((w & 3) * 4 + jt) * 16 + r) * 64 + lane]; o[jt][r] = v; sq += v * v; }
        sq += __shfl_xor(sq, 32);
        const float rstd = __builtin_amdgcn_rsqf(sq * (1.f / 128.f) + EPS) * (1.f - LAMBDA_INIT);
        const float* sub = P.in[24];
#pragma unroll
        for (int jt = 0; jt < 4; ++jt)
#pragma unroll
            for (int r4 = 0; r4 < 4; ++r4) {
                const int dv = 32 * jt + 8 * r4 + 4 * hh; const f32x4 g4 = *(const f32x4*)(sub + dv);
                u32x2 ow; ow.x = pk2(o[jt][4 * r4] * rstd * g4[0], o[jt][4 * r4 + 1] * rstd * g4[1]); ow.y = pk2(o[jt][4 * r4 + 2] * rstd * g4[2], o[jt][4 * r4 + 3] * rstd * g4[3]);
                *(u32x2*)(act1 + (size_t)(qrow0 + l31) * D + h * 128 + dv) = ow;
            }
    }
    __syncthreads();
}

typedef __attribute__((address_space(1))) unsigned gu32;
#define XB_TMO      128
#define XB_XCNT(j)  (256  + 64 * (j))
#define XB_XSUB(j)  (1280 + 64 * (j))
#define XB_XGEN(j)  (2304 + 64 * (j))
#define XB_TOP      3328
#define XB_TOPGEN   3392
#define XCD_BAR_WORDS 3456
#define XB_SPIN_CAP (1u << 18)

__device__ __forceinline__ unsigned xb_ld(unsigned* p)              { return __hip_atomic_load(p, __ATOMIC_RELAXED, __HIP_MEMORY_SCOPE_AGENT); }
__device__ __forceinline__ unsigned xb_add(unsigned* p, unsigned v) { return __hip_atomic_fetch_add(p, v, __ATOMIC_RELAXED, __HIP_MEMORY_SCOPE_AGENT); }
__device__ __forceinline__ unsigned xb_xcc_id() { return (unsigned)__builtin_amdgcn_s_getreg((3 << 11) | 20) & 0xFu; }
#define XB_SPIN(cond, bar) do { unsigned _sp = 0; while (cond) { __builtin_amdgcn_s_sleep(1); \
    if ((++_sp & 255u) == 0u) { if (xb_ld(&(bar)[XB_TMO])) break; if (_sp > XB_SPIN_CAP) { atomicAdd(&(bar)[XB_TMO], 1u); break; } } } } while (0)

struct XcdBarrier {
    unsigned* bar; unsigned x;
    volatile LAS unsigned* st;
};

__device__ __forceinline__ XcdBarrier xcd_barrier_post(unsigned* bar, volatile LAS unsigned* st) {
    XcdBarrier b; b.bar = bar; b.x = xb_xcc_id(); b.st = st;
    if (threadIdx.x == 0) (void)xb_add(&bar[XB_XCNT(b.x)], 1u);
    return b;
}
__device__ __forceinline__ void xcd_barrier_complete(unsigned* bar, unsigned x, unsigned& nloc, unsigned& nx) {
    const unsigned G = gridDim.x * gridDim.y * gridDim.z;
    unsigned sum, cnt, mine, sp = 0u;
    for (;;) {
        sum = 0u; cnt = 0u; mine = 0u;
#pragma unroll
        for (unsigned j = 0; j < 16; ++j) { const unsigned c = xb_ld(&bar[XB_XCNT(j)]); sum += c; cnt += (c > 0u) ? 1u : 0u; mine = (j == x) ? c : mine; }
        if (sum == G) break;
        __builtin_amdgcn_s_sleep(1);
        if ((++sp & 255u) == 0u) { if (xb_ld(&bar[XB_TMO])) break; if (sp > XB_SPIN_CAP) { atomicAdd(&bar[XB_TMO], 1u); break; } }
    }
    nloc = mine > 0u ? mine : 1u; nx = cnt > 0u ? cnt : 1u;
}

__device__ __forceinline__ void xcd_barrier(const XcdBarrier& b) {
    asm volatile("s_waitcnt vmcnt(0)" ::: "memory");
    __syncthreads();
    if (threadIdx.x == 0) {
        unsigned* bar = b.bar;
        __builtin_amdgcn_s_waitcnt(0);
        unsigned nloc = b.st[0], nx = b.st[1];
        if (nloc == 0u) { xcd_barrier_complete(bar, b.x, nloc, nx); b.st[0] = nloc; b.st[1] = nx; }
        const unsigned old = xb_add(&bar[XB_XSUB(b.x)], 1u);
        const unsigned gen = old / nloc;
        if (old + 1u == (gen + 1u) * nloc) {
            __builtin_amdgcn_fence(__ATOMIC_RELEASE, "agent");
            asm volatile("s_waitcnt vmcnt(0)" ::: "memory");
            const unsigned og = xb_add(&bar[XB_TOP], 1u);
            const unsigned tg = og / nx;
            if (og + 1u == (tg + 1u) * nx) xb_add(&bar[XB_TOPGEN], 1u);
            else XB_SPIN(xb_ld(&bar[XB_TOPGEN]) == tg, bar);
            __builtin_amdgcn_fence(__ATOMIC_ACQUIRE, "agent");
            xb_add(&bar[XB_XGEN(b.x)], 1u);
            asm volatile("s_waitcnt vmcnt(0)" ::: "memory");
        } else {
            XB_SPIN(xb_ld(&bar[XB_XGEN(b.x)]) == gen, bar);
            __builtin_amdgcn_fence(__ATOMIC_ACQUIRE, "agent");
            asm volatile("s_waitcnt vmcnt(0)" ::: "memory");
        }
    }
    __syncthreads();
}

#ifndef PHMASK
#define PHMASK 0xFFFF
#endif
#ifndef REP_ATTN
#define REP_ATTN 1
#endif
#ifndef REP_P4
#define REP_P4 1
#endif
#ifndef REP_P2
#define REP_P2 1
#endif
#ifndef REP_P0
#define REP_P0 1
#endif
__global__ void __launch_bounds__(512) fwd_megakernel(Params P) {
    extern __shared__ __attribute__((aligned(16))) unsigned char lds_raw[];
    LAS unsigned char* lds = (LAS unsigned char*)lds_raw;
    cg::grid_group grid = cg::this_grid();
    float* misc = (float*)(P.ws + WS_MISC);
    const int G = gridDim.x, bx = blockIdx.x;
    const char* act0 = (const char*)(P.ws + WS_ACT0 + ACT0_PAD); const char* act1 = (const char*)(P.ws + WS_ACT1);
    float* xc = (float*)(P.ws + WS_XC);
    volatile LAS unsigned* bst = (volatile LAS unsigned*)(lds + 147440);
    if (threadIdx.x < 2) bst[threadIdx.x] = 0u;
    __syncthreads();
    const XcdBarrier bar = xcd_barrier_post((unsigned*)(P.ws + WS_BAR), bst);

    if (PHMASK & 1) phase_p0a(P, lds, misc);
    grid.sync();
    if (PHMASK & 1) phase_p0b(P, misc);
    xcd_barrier(bar);

    Epi E; pg8::Sched S;
    E = Epi{}; E.mode = EM_PROJ0; E.ss = misc + OFF_SS; E.bias0 = misc + OFF_BIAS + B_P0; E.nb0 = 2304; E.bias1 = misc + OFF_BIAS + B_V0;
    E.q = (bf16_t*)(P.ws + R_Q0); E.k = (bf16_t*)(P.ws + R_K0); E.r = (bf16_t*)(P.ws + R_R0); E.vt = (bf16_t*)(P.ws + R_VT); E.t = (float*)(P.ws + R_T0);
    S = pg8::Sched{act0, (const char*)(P.ws + W_P0), (const char*)(P.ws + W_V0), act0, 65, 9, 0, 4, 65, 1024, 0, G, bx};
    if (PHMASK & 2) pg8::gemm_phase(lds, S, E);
    xcd_barrier(bar);
    if (PHMASK & 4) for (int rep = 0; rep < REP_P2; ++rep) for (int it = bx; it < NSEG * 8; it += G) gla_sweep(P, lds, misc, it >> 3, (it >> 1) & 3, it & 1, 0);
    xcd_barrier(bar);
    if (PHMASK & 4) phase_gla_combine(P, misc);
    xcd_barrier(bar);
    if (PHMASK & 8) for (int rep = 0; rep < REP_P4; ++rep) for (int it = bx; it < NSEG * 8; it += G) gla_sweep(P, lds, misc, it >> 3, (it >> 1) & 3, it & 1, 1);
    xcd_barrier(bar);
    if (PHMASK & 8) phase_gla_readout(P);
    xcd_barrier(bar);
    { constexpr int l = 0;
        if (l == 1) {
            E = Epi{}; E.mode = EM_QKV1; E.ss = misc + OFF_SS + 2 * MT; E.bias0 = misc + OFF_BIAS + B_QK1; E.nb0 = 2048; E.bias1 = misc + OFF_BIAS + B_V1;
            E.q = (bf16_t*)(P.ws + R_Q1); E.k = (bf16_t*)(P.ws + R_K1); E.vt = (bf16_t*)(P.ws + R_VT); E.rope = misc + OFF_ROPE;
            S = pg8::Sched{act0, (const char*)(P.ws + W_QK1), (const char*)(P.ws + W_V1), act0, 65, 8, 0, 4, 65, 1024, 0, G, bx};
            if (PHMASK & 2) pg8::gemm_phase(lds, S, E);
            xcd_barrier(bar);
            if (PHMASK & 16) for (int rep = 0; rep < REP_ATTN; ++rep) for (int u = __builtin_amdgcn_readfirstlane(bx); u < 1024; u = __builtin_amdgcn_readfirstlane(u + G)) attn_unit(P, lds, misc, u >> 7, u & 127);
            xcd_barrier(bar);
        }
        E = Epi{}; E.mode = EM_RES;
        E.xs_c = l == 0 ? P.in[2] : xc; E.xs_x = l == 0 ? P.in[0] : P.out; E.xd_c = xc; E.xd_x = P.out;
        E.xrb = (bf16_t*)(P.ws + WS_XR); E.src_f32 = 0; E.dst_f32 = 0;
        E.gate_c = misc + OFF_MOD + (l * 2 + 1) * 6144 + 2048; E.gate_x = misc + OFF_MOD + (l * 2 + 0) * 6144 + 2048;
        E.gs_c = misc + OFF_GS + ((l * 2 + 1) * 2 + 1) * 1024; E.gs_x = misc + OFF_GS + ((l * 2 + 1) * 2 + 0) * 1024;
        E.ss_out = misc + OFF_SS + (1 + 2 * l) * MT; E.act0 = (bf16_t*)act0;
        S = pg8::Sched{act1, (const char*)(P.ws + (l == 0 ? W_O0 : W_O1)), nullptr, nullptr, l == 0 ? 65 : 64, 4, l == 0 ? 0 : 1, 0, 0, 1024, 0, G, bx, 1};
        if (PHMASK & 2) pg8::gemm_phase(lds, S, E);
        xcd_barrier(bar);
        E = Epi{}; E.mode = EM_UP; E.ss = misc + OFF_SS + (1 + 2 * l) * MT; E.bias0 = misc + OFF_BIAS + (l == 0 ? B_UP0 : B_UP1); E.nb0 = NUP;
        E.conv = P.in[27] + (size_t)l * 3 * NUP; E.convb = P.in[28] + (size_t)l * NUP; E.g = (bf16_t*)(P.ws + R_G);
        S = pg8::Sched{act0, (const char*)(P.ws + (l == 0 ? W_UP0 : W_UP1)), nullptr, nullptr, l == 0 ? 69 : 67, 22, l == 0 ? 0 : 2, 0, 0, 1024, 1, G, bx};
        if (PHMASK & 2) pg8::gemm_phase(lds, S, E);
        xcd_barrier(bar);
        E = Epi{}; E.mode = EM_RES;
        E.xs_c = xc; E.xs_x = P.out; E.xd_c = xc; E.xd_x = P.out;
        E.xrb = (bf16_t*)(P.ws + WS_XR); E.src_f32 = 0; E.dst_f32 = 0;
        E.gate_c = misc + OFF_MOD + (l * 2 + 1) * 6144 + 5120; E.gate_x = misc + OFF_MOD + (l * 2 + 0) * 6144 + 5120;
        E.gs_c = l == 0 ? misc + OFF_GS + ((1 * 2 + 0) * 2 + 1) * 1024 : nullptr; E.gs_x = l == 0 ? misc + OFF_GS + ((1 * 2 + 0) * 2 + 0) * 1024 : nullptr;
        E.ss_out = misc + OFF_SS + (2 + 2 * l) * MT; E.act0 = (bf16_t*)act0;
        S = pg8::Sched{(const char*)(P.ws + R_G), (const char*)(P.ws + (l == 0 ? W_DN0 : W_DN1)), nullptr, nullptr, l == 0 ? 65 : 64, 4, l == 0 ? 0 : 1, 0, 0, DFF, 0, G, bx, 1};
        if (PHMASK & 2) pg8::gemm_phase(lds, S, E);
        xcd_barrier(bar);
    }
    { constexpr int l = 1;
        if (l == 1) {
            E = Epi{}; E.mode = EM_QKV1; E.ss = misc + OFF_SS + 2 * MT; E.bias0 = misc + OFF_BIAS + B_QK1; E.nb0 = 2048; E.bias1 = misc + OFF_BIAS + B_V1;
            E.q = (bf16_t*)(P.ws + R_Q1); E.k = (bf16_t*)(P.ws + R_K1); E.vt = (bf16_t*)(P.ws + R_VT); E.rope = misc + OFF_ROPE;
            S = pg8::Sched{act0, (const char*)(P.ws + W_QK1), (const char*)(P.ws + W_V1), act0, 65, 8, 0, 4, 65, 1024, 0, G, bx};
            if (PHMASK & 2) pg8::gemm_phase(lds, S, E);
            xcd_barrier(bar);
            if (PHMASK & 16) for (int rep = 0; rep < REP_ATTN; ++rep) for (int u = __builtin_amdgcn_readfirstlane(bx); u < 1024; u = __builtin_amdgcn_readfirstlane(u + G)) attn_unit(P, lds, misc, u >> 7, u & 127);
            xcd_barrier(bar);
        }
        E = Epi{}; E.mode = EM_RES;
        E.xs_c = l == 0 ? P.in[2] : xc; E.xs_x = l == 0 ? P.in[0] : P.out; E.xd_c = xc; E.xd_x = P.out;
        E.xrb = (bf16_t*)(P.ws + WS_XR); E.src_f32 = 0; E.dst_f32 = 0;
        E.gate_c = misc + OFF_MOD + (l * 2 + 1) * 6144 + 2048; E.gate_x = misc + OFF_MOD + (l * 2 + 0) * 6144 + 2048;
        E.gs_c = misc + OFF_GS + ((l * 2 + 1) * 2 + 1) * 1024; E.gs_x = misc + OFF_GS + ((l * 2 + 1) * 2 + 0) * 1024;
        E.ss_out = misc + OFF_SS + (1 + 2 * l) * MT; E.act0 = (bf16_t*)act0;
        S = pg8::Sched{act1, (const char*)(P.ws + (l == 0 ? W_O0 : W_O1)), nullptr, nullptr, l == 0 ? 65 : 64, 4, l == 0 ? 0 : 1, 0, 0, 1024, 0, G, bx, 1};
        if (PHMASK & 2) pg8::gemm_phase(lds, S, E);
        xcd_barrier(bar);
        E = Epi{}; E.mode = EM_UP; E.ss = misc + OFF_SS + (1 + 2 * l) * MT; E.bias0 = misc + OFF_BIAS + (l == 0 ? B_UP0 : B_UP1); E.nb0 = NUP;
        E.conv = P.in[27] + (size_t)l * 3 * NUP; E.convb = P.in[28] + (size_t)l * NUP; E.g = (bf16_t*)(P.ws + R_G);
        S = pg8::Sched{act0, (const char*)(P.ws + (l == 0 ? W_UP0 : W_UP1)), nullptr, nullptr, l == 0 ? 69 : 67, 22, l == 0 ? 0 : 2, 0, 0, 1024, 1, G, bx};
        if (PHMASK & 2) pg8::gemm_phase(lds, S, E);
        xcd_barrier(bar);
        E = Epi{}; E.mode = EM_RES;
        E.xs_c = xc; E.xs_x = P.out; E.xd_c = xc; E.xd_x = P.out;
        E.xrb = (bf16_t*)(P.ws + WS_XR); E.src_f32 = 0; E.dst_f32 = 0;
        E.gate_c = misc + OFF_MOD + (l * 2 + 1) * 6144 + 5120; E.gate_x = misc + OFF_MOD + (l * 2 + 0) * 6144 + 5120;
        E.gs_c = l == 0 ? misc + OFF_GS + ((1 * 2 + 0) * 2 + 1) * 1024 : nullptr; E.gs_x = l == 0 ? misc + OFF_GS + ((1 * 2 + 0) * 2 + 0) * 1024 : nullptr;
        E.ss_out = misc + OFF_SS + (2 + 2 * l) * MT; E.act0 = (bf16_t*)act0;
        S = pg8::Sched{(const char*)(P.ws + R_G), (const char*)(P.ws + (l == 0 ? W_DN0 : W_DN1)), nullptr, nullptr, l == 0 ? 65 : 64, 4, l == 0 ? 0 : 1, 0, 0, DFF, 0, G, bx, 1};
        if (PHMASK & 2) pg8::gemm_phase(lds, S, E);
        xcd_barrier(bar);
    }
    {
        int tid_ = threadIdx.x; asm volatile("" : "+v"(tid_));
        const int lane = tid_ & 63, gw = bx * 8 + (tid_ >> 6);
        for (int row0 = gw; row0 < LX; row0 += 2 * G * 8) {
            const int row1 = row0 + G * 8; const bool has1 = row1 < LX; const int r1 = has1 ? row1 : row0;
            const float rs0 = __builtin_amdgcn_rsqf(misc[OFF_SS + 4 * MT + 256 + row0] * (1.f / D) + EPS), rs1 = __builtin_amdgcn_rsqf(misc[OFF_SS + 4 * MT + 256 + r1] * (1.f / D) + EPS);
            f32x4 v0[4], v1[4];
#pragma unroll
            for (int j = 0; j < 4; ++j) { const int c = 4 * lane + 256 * j; const bf16_t* xr = (const bf16_t*)(P.ws + WS_XR);
                const u32x2 a0 = __builtin_nontemporal_load((const u32x2*)(xr + (size_t)(256 + row0) * D + c)), a1 = __builtin_nontemporal_load((const u32x2*)(xr + (size_t)(256 + r1) * D + c));
                v0[j] = (f32x4){bflo(a0.x), bfhi(a0.x), bflo(a0.y), bfhi(a0.y)}; v1[j] = (f32x4){bflo(a1.x), bfhi(a1.x), bflo(a1.y), bfhi(a1.y)}; }
#pragma unroll
            for (int j = 0; j < 4; ++j) { const int c = 4 * lane + 256 * j; const f32x4 fn = *(const f32x4*)(P.in[30] + c);
                __builtin_nontemporal_store(v0[j] * rs0 * fn, (f32x4*)(P.out + (size_t)row0 * D + c)); if (has1) __builtin_nontemporal_store(v1[j] * rs1 * fn, (f32x4*)(P.out + (size_t)row1 * D + c)); }
        }
    }
}

constexpr int LDS_BYTES = 147456;
extern "C" void kernel_launch(void* const* d_in, const int* in_sizes, int n_in, void* d_out, int out_size, void* d_ws, size_t ws_size, hipStream_t stream) {
    static int grid = 0;
    if (grid == 0) {
        int dev = 0, cus = 0, per_cu = 0;
        hipGetDevice(&dev);
        hipDeviceGetAttribute(&cus, hipDeviceAttributeMultiprocessorCount, dev);
        hipFuncSetAttribute((const void*)fwd_megakernel, hipFuncAttributeMaxDynamicSharedMemorySize, LDS_BYTES);
        hipOccupancyMaxActiveBlocksPerMultiprocessor(&per_cu, (const void*)fwd_megakernel, 512, LDS_BYTES);
        if (per_cu < 1) { fprintf(stderr, "kernel_launch: occupancy query says %d blocks/CU\n", per_cu); per_cu = 1; }
        grid = cus;
        if (ws_size < WS_END) { fprintf(stderr, "kernel_launch: workspace too small (%zu < %zu)\n", ws_size, (size_t)WS_END); grid = -1; }
        if (n_in != 31) { fprintf(stderr, "kernel_launch: expected 31 inputs, got %d\n", n_in); grid = -1; }
    }
    if (grid < 0) return;
    Params p{};
    for (int i = 0; i < 31; ++i) p.in[i] = (const float*)d_in[i];
    p.out = (float*)d_out; p.ws = (unsigned char*)d_ws;
    unsigned char* ws = (unsigned char*)d_ws;
    auto mk = [](const float* src, void* dst, int K, int Nsrc, int nrows, int map) { Piece q; q.src = src; q.dst = (bf16_t*)dst; q.K = K; q.Nsrc = Nsrc; q.nrows = nrows; q.map = map; return q; };
    p.pc[0] = mk(p.in[8], ws + W_P0, 1024, 512, 512, 0);
    p.pc[1] = mk(p.in[9], ws + W_P0 + (size_t)512 * 2048, 1024, 512, 512, 0);
    p.pc[2] = mk(p.in[11], ws + W_P0 + (size_t)1024 * 2048, 1024, 1024, 1024, 0);
    p.pc[3] = mk(p.in[10], ws + W_V0, 1024, 1024, 1024, 0);
    p.pc[4] = mk(p.in[16], ws + W_O0, 1024, 1024, 1024, 0);
    p.pc[5] = mk(p.in[26], ws + W_UP0, 1024, NUP, NUP, 1);
    p.pc[6] = mk(p.in[29], ws + W_DN0, DFF, 1024, 1024, 0);
    p.pc[7] = mk(p.in[17], ws + W_QK1, 1024, 1024, 1024, 2);
    p.pc[8] = mk(p.in[18], ws + W_QK1 + (size_t)1024 * 2048, 1024, 1024, 1024, 2);
    p.pc[9] = mk(p.in[19], ws + W_V1, 1024, 1024, 1024, 0);
    p.pc[10] = mk(p.in[25], ws + W_O1, 1024, 1024, 1024, 0);
    p.pc[11] = mk(p.in[26] + (size_t)1024 * NUP, ws + W_UP1, 1024, NUP, NUP, 1);
    p.pc[12] = mk(p.in[29] + (size_t)DFF * 1024, ws + W_DN1, DFF, 1024, 1024, 0);
    if (hipMemsetAsync((char*)d_ws + WS_BAR, 0, 16384, stream) != hipSuccess) { fprintf(stderr, "memset failed\n"); return; }
    void* args[] = {&p};
    hipError_t e = hipLaunchCooperativeKernel((const void*)fwd_megakernel, dim3(grid), dim3(512), args, LDS_BYTES, stream);
    if (e != hipSuccess) fprintf(stderr, "cooperative launch failed: %s (grid %d)\n", hipGetErrorString(e), grid);
}
```

```cpp
#include <hip/hip_runtime.h>
#include <hip/hip_cooperative_groups.h>
#include <cstdio>
#include <cstdint>
namespace cg = cooperative_groups;

#define LAS __attribute__((address_space(3)))
#define DI __device__ __forceinline__
typedef unsigned short bf16_t;
typedef short bf16x8 __attribute__((ext_vector_type(8)));
typedef float f32x2 __attribute__((ext_vector_type(2)));
typedef float f32x4 __attribute__((ext_vector_type(4)));
typedef float f32x16 __attribute__((ext_vector_type(16)));
typedef unsigned u32x2 __attribute__((ext_vector_type(2)));
typedef unsigned u32x4 __attribute__((ext_vector_type(4)));
typedef __bf16 bf16x2_t __attribute__((ext_vector_type(2)));

DI unsigned pk2(float lo, float hi) { f32x2 v = {lo, hi}; bf16x2_t b = __builtin_convertvector(v, bf16x2_t); return __builtin_bit_cast(unsigned, b); }
DI float bf2f(bf16_t b) { return __uint_as_float(((unsigned)b) << 16); }
DI float bflo(unsigned w) { return __uint_as_float(w << 16); }
DI float bfhi(unsigned w) { return __uint_as_float(w & 0xffff0000u); }
DI float silu_f(float x) { return x * __builtin_amdgcn_rcpf(1.f + __builtin_amdgcn_exp2f(-1.4426950408889634f * x)); }
DI int crow(int r, int hh) { return (r & 3) + 8 * (r >> 2) + 4 * hh; }
DI float wave_sum(float v) {
#pragma unroll
    for (int o = 1; o < 64; o <<= 1) v += __shfl_xor(v, o);
    return v;
}

constexpr int D = 1024, LX = 16384, LC = 256, MT = LX + LC;
constexpr int DFF = 2816, NUP = 5632;
constexpr float EPS = 1e-6f;
constexpr float LAMBDA_INIT = 0.35550906759297316f;
constexpr float QSCALE1 = 0.125f * 1.4426950408889634f;
constexpr int NSEG = 32;

constexpr size_t MiB = 1u << 20;
constexpr size_t WS_MISC = 0;
constexpr size_t WS_W = 4 * MiB;
constexpr size_t WS_BAR = 2 * MiB;
constexpr size_t W_P0 = WS_W, W_V0 = W_P0 + 2304 * 2048, W_O0 = W_V0 + 2 * MiB, W_UP0 = W_O0 + 2 * MiB, W_DN0 = W_UP0 + 11 * MiB;
constexpr size_t W_QK1 = W_DN0 + 5632 * 1024, W_V1 = W_QK1 + 4 * MiB, W_O1 = W_V1 + 2 * MiB, W_UP1 = W_O1 + 2 * MiB, W_DN1 = W_UP1 + 11 * MiB;
constexpr size_t WS_ACT0 = 54 * MiB, ACT0_PAD = 16384;
constexpr size_t WS_SB = WS_ACT0;
constexpr size_t WS_ACT1 = 88 * MiB;
constexpr size_t WS_R1 = 121 * MiB;
constexpr size_t R_Q0 = WS_R1, R_K0 = R_Q0 + (size_t)MT * 512 * 2, R_R0 = R_K0 + (size_t)MT * 512 * 2, R_VT = R_R0 + (size_t)MT * 1024 * 2, R_T0 = R_VT + (size_t)MT * 1024 * 2;
constexpr size_t R_Q1 = WS_R1, R_K1 = R_Q1 + (size_t)MT * 1024 * 2;
constexpr size_t R_G = WS_R1;
constexpr size_t WS_XC = 221 * MiB;
constexpr size_t WS_XR = 222 * MiB;
constexpr size_t WS_END = 255 * MiB;
static_assert(WS_XR + (size_t)MT * D * 2 <= WS_END, "XR");
static_assert(W_DN1 + 5632 * 1024 <= WS_ACT0, "weights");
static_assert(R_T0 + (size_t)MT * 32 * 4 <= WS_XC && R_G + (size_t)MT * DFF * 2 <= WS_XC, "R1");
static_assert((size_t)NSEG * 8 * 32768 * 4 <= WS_ACT1 - WS_SB, "SB");
constexpr int OFF_MOD = 0, OFF_SS = 32768, OFF_BIAS = 131072, OFF_GS = 172032, OFF_ROPE = 196608, OFF_LAM = 204800, OFF_ASEG = 212992;
constexpr int B_P0 = 0, B_V0 = 4608, B_UP0 = 6656, B_QK1 = 17920, B_V1 = 22016, B_UP1 = 24064;

struct Piece { const float* src; bf16_t* dst; int K, Nsrc, nrows, map; };
struct Params { const float* in[31]; float* out; unsigned char* ws; Piece pc[13]; };

namespace pg8 {
constexpr int BM = 256, BK = 64, HALF = 128, HTB = HALF * BK * 2, STAGE_BYTES = 8 * HTB, NXCD = 8, WGM = 4;
DI int lds_byte(int r, int c) { const int st = (r >> 4) * 2 + (c >> 5), rr = r & 15, cc = c & 31, ob = rr * 64 + cc * 2; return st * 1024 + (ob ^ (((ob >> 9) & 1) << 5)); }
DI void stage_rc(int b, int& R, int& C) { const int st = b / 1024, sb = b % 1024, swz = sb ^ (((sb >> 9) & 1) << 5); R = (st >> 1) * 16 + swz / 64; C = (st & 1) * 32 + (swz % 64) / 2; }
DI int perm32(int rho) { const int n = rho >> 4, i = rho & 15; return 8 * (i >> 2) + 4 * n + (i & 3); }

struct Unit { const char* A; const char* B; int pm, pn, kind, base, lo, hi; };

DI void tile_of(int wgid, int nM, int nN, int& pm, int& pn) {
    const int nwg = nM * nN;
    { const int q = nwg / NXCD, r = nwg % NXCD, xcd = wgid % NXCD, off = wgid / NXCD; wgid = (xcd < r ? xcd * (q + 1) : r * (q + 1) + (xcd - r) * q) + off; }
    const int nig = WGM * nN, gid = wgid / nig, fm = gid * WGM, gsz = (nM - fm) < WGM ? (nM - fm) : WGM;
    pm = fm + ((wgid % nig) % gsz); pn = (wgid % nig) / gsz;
}

struct Sched {
    const char *A0, *B0, *A1, *B1; int nM0, nN0, pm0, nM1, nN1, K, halo, G, c, bjm;
    DI bool next(int i, Unit& u) const {
        const long L = (long)i * G + c; const int n0 = nM0 * nN0, n1 = nM1 * nN1;
        if (L >= n0 + n1) return false;
        int pm, pn;
        if (L < n0) {
            tile_of((int)L, nM0, nN0, pm, pn); pm += pm0; u.kind = 0; u.pm = pm; u.pn = pn;
            if (halo) { const int base = pm < 2 ? 248 * pm : 256 + 248 * (pm - 2); u.base = base; u.lo = pm < 2 ? 0 : 256; u.hi = pm < 2 ? 256 : MT; u.A = A0 + ((long)base - 1) * K * 2; }
            else { u.base = 0; u.lo = 0; u.hi = 0; u.A = A0 + (size_t)pm * 256 * K * 2; }
            u.B = B0 + (size_t)pn * 256 * K * 2;
        } else {
            tile_of((int)(L - n0), nM1, nN1, pm, pn); u.kind = 1; u.pm = pm; u.pn = pn; u.base = 0; u.lo = 0; u.hi = 0;
            u.A = A1 + (size_t)pm * 256 * K * 2; u.B = B1 + (size_t)pn * 256 * K * 2;
        }
        return true;
    }
};

template <class Epi>
DI void gemm_phase(LAS unsigned char* lds, const Sched& S, const Epi& E) {
    int tid_ = threadIdx.x; asm volatile("" : "+v"(tid_)); const int tid = tid_, wid = __builtin_amdgcn_readfirstlane(tid >> 6), lane = tid & 63, wr = wid >> 2, wc = wid & 3, fr = lane & 15, fq = lane >> 4;
    const int K = S.K, nt = K / BK;
    unsigned voffA[2], voffB[2];
#pragma unroll
    for (int i = 0; i < 2; ++i) { int R, C; stage_rc(tid * 16 + i * 8192, R, C); const int Rb = S.bjm ? 64 * (R >> 5) + perm32(R & 31) : (R & ~31) + perm32(R & 31); const int Ra = S.halo ? 62 * (R >> 6) + 4 * (R & 15) + ((R >> 4) & 3) : R;
        voffA[i] = (unsigned)(Ra * K + C) * 2u; voffB[i] = (unsigned)(Rb * K + C) * 2u; }
    const size_t kstep = (size_t)(BK * 2);
    const size_t hstepB = S.bjm ? (size_t)32 * K * 2 : (size_t)HALF * K * 2;
    const size_t hstepA = S.halo ? (size_t)124 * K * 2 : (size_t)HALF * K * 2;
    const unsigned ldsw = (unsigned)wid * 1024u;
    const int aoff = lds_byte(wr * 64 + fr, fq * 8), boff = lds_byte(wc * 32 + fr, fq * 8);
#define PG8_SA(b, h) (((b) * 2 + (h)) * HTB)
#define PG8_SB(b, h) ((4 + (b) * 2 + (h)) * HTB)
#define PG8_STAGE(bufoff, gbase, voff) do { _Pragma("unroll") for (int _i = 0; _i < 2; ++_i) \
        __builtin_amdgcn_global_load_lds((const unsigned*)((const char*)(gbase) + (voff)[_i]), (LAS unsigned*)(lds + (bufoff) + ldsw + _i * 8192), 16, 0, 0); } while (0)
#define PG8_LDA(dst, b, h) do { _Pragma("unroll") for (int m = 0; m < 4; ++m) _Pragma("unroll") for (int k = 0; k < 2; ++k) dst[m][k] = *(const LAS bf16x8*)(lds + PG8_SA(b, h) + aoff + m * 2048 + k * 1024); } while (0)
#define PG8_LDB(dst, b, h) do { _Pragma("unroll") for (int n = 0; n < 2; ++n) _Pragma("unroll") for (int k = 0; k < 2; ++k) dst[n][k] = *(const LAS bf16x8*)(lds + PG8_SB(b, h) + boff + n * 2048 + k * 1024); } while (0)
#define PG8_MMA(ai, bj, At, Bt) do { __builtin_amdgcn_s_setprio(1); _Pragma("unroll") for (int m = 0; m < 4; ++m) _Pragma("unroll") for (int n = 0; n < 2; ++n) _Pragma("unroll") for (int k = 0; k < 2; ++k) \
        acc[ai][bj][m][n] = __builtin_amdgcn_mfma_f32_16x16x32_bf16(Bt[n][k], At[m][k], acc[ai][bj][m][n], 0, 0, 0); __builtin_amdgcn_s_setprio(0); } while (0)
#define PG8_WAIT_V(n) asm volatile("s_waitcnt vmcnt(" #n ")" ::: "memory")
#define PG8_WAIT_L(n) asm volatile("s_waitcnt lgkmcnt(" #n ")" ::: "memory")
#define PG8_BAR __builtin_amdgcn_s_barrier()
#define PG8_SCHED __builtin_amdgcn_sched_barrier(0)
    Unit cur, nxt; int ui = 0;
    if (!S.next(0, cur)) return;
    f32x4 acc[2][2][4][2];
#pragma unroll
    for (int a = 0; a < 2; ++a)
#pragma unroll
        for (int b = 0; b < 2; ++b)
#pragma unroll
            for (int m = 0; m < 4; ++m)
#pragma unroll
                for (int n = 0; n < 2; ++n) acc[a][b][m][n] = (f32x4){0.f, 0.f, 0.f, 0.f};
    bf16x8 At[4][2], B0[2][2], B1[2][2];
    const char* cA = cur.A; const char* cB = cur.B;
    PG8_STAGE(PG8_SB(0, 0), cB, voffB); PG8_STAGE(PG8_SB(0, 1), cB + hstepB, voffB); PG8_STAGE(PG8_SA(0, 0), cA, voffA); PG8_STAGE(PG8_SA(0, 1), cA + hstepA, voffA);
    if (wr == 1) PG8_BAR;
    PG8_WAIT_V(2); PG8_BAR;
    PG8_STAGE(PG8_SB(1, 0), cB + kstep, voffB); PG8_STAGE(PG8_SA(1, 0), cA + kstep, voffA); PG8_STAGE(PG8_SB(1, 1), cB + hstepB + kstep, voffB);
    PG8_WAIT_V(6); PG8_BAR;
    for (;;) {
        const bool has_next = S.next(ui + 1, nxt);
        const char* nA = has_next ? nxt.A : cA; const char* nB = has_next ? nxt.B : cB;
        for (int t = 0; t < nt; t += 2) {
            const bool last = (t == nt - 2);
            const char* a1 = cA + (size_t)(t + 1) * kstep;
            const char* a2 = last ? nA : cA + (size_t)(t + 2) * kstep; const char* b2 = last ? nB : cB + (size_t)(t + 2) * kstep;
            const char* a3 = a2 + kstep; const char* b3 = b2 + kstep;
            PG8_LDB(B0, 0, 0); PG8_LDB(B1, 0, 1); PG8_SCHED; PG8_LDA(At, 0, 0); PG8_STAGE(PG8_SA(1, 1), a1 + hstepA, voffA);
            PG8_WAIT_V(8); PG8_WAIT_L(0); PG8_BAR; PG8_MMA(0, 0, At, B0); PG8_MMA(0, 1, At, B1); PG8_BAR; PG8_SCHED;
            PG8_LDA(At, 0, 1); PG8_STAGE(PG8_SB(0, 0), b2, voffB); PG8_STAGE(PG8_SB(0, 1), b2 + hstepB, voffB); PG8_STAGE(PG8_SA(0, 0), a2, voffA);
            PG8_WAIT_V(8); PG8_WAIT_L(0); PG8_BAR; PG8_MMA(1, 0, At, B0); PG8_MMA(1, 1, At, B1); PG8_BAR; PG8_SCHED;
            PG8_LDB(B0, 1, 0); PG8_LDB(B1, 1, 1); PG8_SCHED; PG8_LDA(At, 1, 0); PG8_STAGE(PG8_SA(0, 1), a2 + hstepA, voffA);
            PG8_WAIT_V(8); PG8_WAIT_L(0); PG8_BAR; PG8_MMA(0, 0, At, B0); PG8_MMA(0, 1, At, B1); PG8_BAR; PG8_SCHED;
            PG8_LDA(At, 1, 1); PG8_STAGE(PG8_SB(1, 0), b3, voffB); PG8_STAGE(PG8_SB(1, 1), b3 + hstepB, voffB); PG8_STAGE(PG8_SA(1, 0), a3, voffA);
            PG8_WAIT_V(8); PG8_WAIT_L(0); PG8_BAR; PG8_MMA(1, 0, At, B0); PG8_MMA(1, 1, At, B1); PG8_BAR; PG8_SCHED;
        }
        if (wr == 0) PG8_BAR;
        E(acc, cur, wr, wc, fr, fq);
        if (!has_next) break;
#pragma unroll
        for (int a = 0; a < 2; ++a)
#pragma unroll
            for (int b = 0; b < 2; ++b)
#pragma unroll
                for (int m = 0; m < 4; ++m)
#pragma unroll
                    for (int n = 0; n < 2; ++n) acc[a][b][m][n] = (f32x4){0.f, 0.f, 0.f, 0.f};
        cur = nxt; cA = nA; cB = nB; ++ui;
        if (wr == 1) PG8_BAR;
    }
    PG8_WAIT_V(0);
    PG8_BAR;
#undef PG8_SA
#undef PG8_SB
#undef PG8_STAGE
#undef PG8_LDA
#undef PG8_LDB
#undef PG8_MMA
#undef PG8_WAIT_V
#undef PG8_WAIT_L
#undef PG8_BAR
#undef PG8_SCHED
}
}

#define SCHED_FENCE() do { asm volatile("" ::: "memory"); __builtin_amdgcn_sched_barrier(0); } while (0)
#ifdef USE_SHFL
#define ROT_PREV(x) __shfl((x), lprev)
#define ROT_NEXT(x) __shfl((x), lnext)
#else
#define ROT_PREV(x) __int_as_float(__builtin_amdgcn_mov_dpp(__float_as_int(x), 0x121, 0xf, 0xf, true))
#define ROT_NEXT(x) __int_as_float(__builtin_amdgcn_mov_dpp(__float_as_int(x), 0x12F, 0xf, 0xf, true))
#endif
enum { EM_PROJ0 = 0, EM_QKV1 = 1, EM_RES = 2, EM_UP = 3 };
struct Epi {
    int mode;
    const float* ss;
    const float* bias0; int nb0;
    const float* bias1;
    bf16_t *q, *k, *r, *vt; float* t; const float* rope;
    const float *xs_c, *xs_x; float *xd_c, *xd_x; const float *gate_c, *gate_x, *gs_c, *gs_x; float* ss_out; bf16_t* act0;
    bf16_t* xrb; int src_f32, dst_f32;
    const float *conv, *convb; bf16_t* g;

    DI void operator()(f32x4 (&acc)[2][2][4][2], const pg8::Unit& u, int wr, int wc, int fr, int fq) const {
        const int colt = 32 * wc + 8 * fq;
#ifndef NO_RES
        if (mode == EM_RES) {
            const int path = (u.pm == 0);
            const float* xs = path ? xs_c : xs_x; float* xd = path ? xd_c : xd_x; const float* gate = path ? gate_c : gate_x; const float* gs = path ? gs_c : gs_x;
            const int rowoff = path ? 0 : 256;
            f32x4 gv[2][2], sv[2][2];
#pragma unroll
            for (int bj = 0; bj < 2; ++bj)
#pragma unroll
                for (int n = 0; n < 2; ++n) { const int c = u.pn * 256 + 64 * wc + 32 * bj + 8 * fq + 4 * n; gv[bj][n] = *(const f32x4*)(gate + c); sv[bj][n] = gs ? *(const f32x4*)(gs + c) : (f32x4){0.f, 0.f, 0.f, 0.f}; }
#pragma unroll
            for (int ai = 0; ai < 2; ++ai)
#pragma unroll
                for (int m = 0; m < 4; ++m) {
                    const int row = u.pm * 256 + ai * 128 + wr * 64 + m * 16 + fr; const size_t lo = (size_t)(row - rowoff) * D;
                    float ssum = 0.f;
#pragma unroll
                    for (int bj = 0; bj < 2; ++bj) {
                        const int c = u.pn * 256 + 64 * wc + 32 * bj + 8 * fq;
                        f32x4 x0, x1;
                        if (src_f32) { x0 = *(const f32x4*)(xs + lo + c); x1 = *(const f32x4*)(xs + lo + c + 4); }
                        else { const u32x4 rv = *(const u32x4*)(xrb + (size_t)row * D + c); x0 = (f32x4){bflo(rv.x), bfhi(rv.x), bflo(rv.y), bfhi(rv.y)}; x1 = (f32x4){bflo(rv.z), bfhi(rv.z), bflo(rv.w), bfhi(rv.w)}; }
                        const f32x4 y0 = x0 + gv[bj][0] * acc[ai][bj][m][0], y1 = x1 + gv[bj][1] * acc[ai][bj][m][1];
                        if (dst_f32) { *(f32x4*)(xd + lo + c) = y0; *(f32x4*)(xd + lo + c + 4) = y1; }
                        else { u32x4 wv; wv.x = pk2(y0[0], y0[1]); wv.y = pk2(y0[2], y0[3]); wv.z = pk2(y1[0], y1[1]); wv.w = pk2(y1[2], y1[3]); *(u32x4*)(xrb + (size_t)row * D + c) = wv; }
                        ssum += (y0[0] * y0[0] + y0[1] * y0[1]) + (y0[2] * y0[2] + y0[3] * y0[3]) + (y1[0] * y1[0] + y1[1] * y1[1]) + (y1[2] * y1[2] + y1[3] * y1[3]);
                        if (gs) { const f32x4 a0 = y0 * sv[bj][0], a1 = y1 * sv[bj][1]; u32x4 w; w.x = pk2(a0[0], a0[1]); w.y = pk2(a0[2], a0[3]); w.z = pk2(a1[0], a1[1]); w.w = pk2(a1[2], a1[3]);
                            *(u32x4*)(act0 + (size_t)row * D + c) = w; }
                    }
                    ssum += __shfl_xor(ssum, 16); ssum += __shfl_xor(ssum, 32);
                    if (fq == 0) atomicAdd(ss_out + row, ssum);
                }
            return;
        }
#endif
#ifndef NO_UP
        if (mode == EM_UP) {
            const int path = (u.pm < 2);
            {
                f32x4 bv[2][2]; float rsv[2][4];
#pragma unroll
                for (int bj = 0; bj < 2; ++bj)
#pragma unroll
                    for (int n = 0; n < 2; ++n) bv[bj][n] = *(const f32x4*)(bias0 + path * nb0 + u.pn * 256 + bj * 128 + colt + 4 * n);
#pragma unroll
                for (int ai = 0; ai < 2; ++ai)
#pragma unroll
                    for (int m = 0; m < 4; ++m) { const int grow = u.base + 62 * (2 * ai + wr) - 1 + 4 * fr + m; const int gcl = grow < 0 ? 0 : (grow >= MT ? MT - 1 : grow); rsv[ai][m] = ss[gcl]; }
#pragma unroll
                for (int ai = 0; ai < 2; ++ai)
#pragma unroll
                    for (int m = 0; m < 4; ++m) {
                        const int grow = u.base + 62 * (2 * ai + wr) - 1 + 4 * fr + m; const bool valid = grow >= u.lo && grow < u.hi;
                        const float rs = __builtin_amdgcn_rsqf(rsv[ai][m] * (1.f / D) + EPS);
#pragma unroll
                        for (int bj = 0; bj < 2; ++bj)
#pragma unroll
                            for (int n = 0; n < 2; ++n) { f32x4 v = acc[ai][bj][m][n] * rs + bv[bj][n]; if (!valid) v = (f32x4){0.f, 0.f, 0.f, 0.f}; acc[ai][bj][m][n] = v; }
                    }
            }
            SCHED_FENCE();
#pragma unroll
            for (int bj = 0; bj < 2; ++bj) {
                f32x4 cw[2][4];
#pragma unroll
                for (int n = 0; n < 2; ++n) { const int oc = (bj ? DFF : 0) + u.pn * 128 + colt + 4 * n;
                    cw[n][0] = *(const f32x4*)(conv + oc); cw[n][1] = *(const f32x4*)(conv + NUP + oc); cw[n][2] = *(const f32x4*)(conv + 2 * NUP + oc); cw[n][3] = *(const f32x4*)(convb + oc); }
#pragma unroll
                for (int ai = 0; ai < 2; ++ai)
#pragma unroll
                    for (int n = 0; n < 2; ++n) {
                        f32x4 tmp[4];
                        asm volatile("" : "+v"(acc[ai][bj][0][n]), "+v"(acc[ai][bj][1][n]), "+v"(acc[ai][bj][2][n]), "+v"(acc[ai][bj][3][n]));
#pragma unroll
                        for (int m = 0; m < 4; ++m) {
                            f32x4 pv, nv;
                            if (m > 0) pv = acc[ai][bj][m - 1][n];
                            else {
#pragma unroll
                                for (int j = 0; j < 4; ++j) pv[j] = __int_as_float(__builtin_amdgcn_mov_dpp(__float_as_int(acc[ai][bj][3][n][j]), 0x111, 0xf, 0xf, true)); }
                            if (m < 3) nv = acc[ai][bj][m + 1][n];
                            else {
#pragma unroll
                                for (int j = 0; j < 4; ++j) nv[j] = __int_as_float(__builtin_amdgcn_mov_dpp(__float_as_int(acc[ai][bj][0][n][j]), 0x101, 0xf, 0xf, true)); }
                            tmp[m] = cw[n][0] * pv + cw[n][1] * acc[ai][bj][m][n] + cw[n][2] * nv + cw[n][3];
                        }
#pragma unroll
                        for (int m = 0; m < 4; ++m) acc[ai][bj][m][n] = tmp[m];
                        asm volatile("" : "+v"(acc[ai][bj][0][n]), "+v"(acc[ai][bj][1][n]), "+v"(acc[ai][bj][2][n]), "+v"(acc[ai][bj][3][n]));
                    }
                SCHED_FENCE();
            }
#pragma unroll
            for (int ai = 0; ai < 2; ++ai) {
                const int bb = u.base + 62 * (2 * ai + wr) - 1;
#pragma unroll
                for (int m = 0; m < 4; ++m) {
                    const int lr = 4 * fr + m, orow = bb + lr;
                    if (lr >= 1 && lr <= 62 && orow >= u.lo && orow < u.hi) {
                        f32x4 g0, g1;
#pragma unroll
                        for (int j = 0; j < 4; ++j) { g0[j] = silu_f(acc[ai][0][m][0][j]) * acc[ai][1][m][0][j]; g1[j] = silu_f(acc[ai][0][m][1][j]) * acc[ai][1][m][1][j]; }
                        u32x4 w; w.x = pk2(g0[0], g0[1]); w.y = pk2(g0[2], g0[3]); w.z = pk2(g1[0], g1[1]); w.w = pk2(g1[2], g1[3]);
                        *(u32x4*)(g + (size_t)orow * DFF + u.pn * 128 + colt) = w;
                    }
                    SCHED_FENCE();
                }
            }
            return;
        }
#endif
#ifndef NO_PROJ
        if (u.kind == 1) {
            const int path = (u.pn == 0);
            f32x4 rs[2][2];
#pragma unroll
            for (int bj = 0; bj < 2; ++bj)
#pragma unroll
                for (int n = 0; n < 2; ++n) { const f32x4 s4 = *(const f32x4*)(ss + u.pn * 256 + bj * 128 + colt + 4 * n);
#pragma unroll
                    for (int j = 0; j < 4; ++j) rs[bj][n][j] = __builtin_amdgcn_rsqf(s4[j] * (1.f / D) + EPS); }
#pragma unroll
            for (int ai = 0; ai < 2; ++ai)
#pragma unroll
                for (int m = 0; m < 4; ++m) {
                    const int row = u.pm * 256 + ai * 128 + wr * 64 + m * 16 + fr; const float b = bias1[path * 1024 + row];
#pragma unroll
                    for (int bj = 0; bj < 2; ++bj) {
                        const f32x4 v0 = acc[ai][bj][m][0] * rs[bj][0] + b, v1 = acc[ai][bj][m][1] * rs[bj][1] + b;
                        if (mode == EM_QKV1) {
                            const int gb = u.pn * 256 + bj * 128 + 32 * wc + 16 * (fq >> 1) + 4 * (fq & 1);
                            *(u32x2*)(vt + (size_t)row * MT + gb) = (u32x2){pk2(v0[0], v0[1]), pk2(v0[2], v0[3])};
                            *(u32x2*)(vt + (size_t)row * MT + gb + 8) = (u32x2){pk2(v1[0], v1[1]), pk2(v1[2], v1[3])};
                        } else {
                        u32x4 w; w.x = pk2(v0[0], v0[1]); w.y = pk2(v0[2], v0[3]); w.z = pk2(v1[0], v1[1]); w.w = pk2(v1[2], v1[3]);
                        *(u32x4*)(vt + (size_t)row * MT + u.pn * 256 + bj * 128 + colt) = w;
                        }
                    }
                }
            return;
        }
        {
            const int path = (u.pm == 0);
            f32x4 bv[2][2];
#pragma unroll
            for (int bj = 0; bj < 2; ++bj)
#pragma unroll
                for (int n = 0; n < 2; ++n) bv[bj][n] = *(const f32x4*)(bias0 + path * nb0 + u.pn * 256 + bj * 128 + colt + 4 * n);
#pragma unroll
            for (int ai = 0; ai < 2; ++ai)
#pragma unroll
                for (int m = 0; m < 4; ++m) {
                    const int row = u.pm * 256 + ai * 128 + wr * 64 + m * 16 + fr;
                    const float rs = __builtin_amdgcn_rsqf(ss[row] * (1.f / D) + EPS);
#pragma unroll
                    for (int bj = 0; bj < 2; ++bj) {
                        f32x4 v0 = acc[ai][bj][m][0] * rs + bv[bj][0], v1 = acc[ai][bj][m][1] * rs + bv[bj][1];
                        const int gc = u.pn * 256 + bj * 128 + colt;
                        if (mode == EM_PROJ0) {
                            if (u.pn == 8) { if (bj == 0 && wc == 0) { *(f32x4*)(t + (size_t)row * 32 + colt) = v0; *(f32x4*)(t + (size_t)row * 32 + colt + 4) = v1; } continue; }
                            bf16_t* dst;
                            if (u.pn < 2) { v0 = v0 * 0.08838834764831845f; v1 = v1 * 0.08838834764831845f; dst = q + (size_t)row * 512 + gc; }
                            else if (u.pn < 4) dst = k + (size_t)row * 512 + (gc - 512);
                            else {
#pragma unroll
                                for (int j = 0; j < 4; ++j) { v0[j] = silu_f(v0[j]); v1[j] = silu_f(v1[j]); }
                                dst = r + (size_t)row * 1024 + (gc - 1024); }
                            u32x4 w; w.x = pk2(v0[0], v0[1]); w.y = pk2(v0[2], v0[3]); w.z = pk2(v1[0], v1[1]); w.w = pk2(v1[2], v1[3]);
                            *(u32x4*)dst = w;
                        } else {
                            if (row >= 256) {
                                const int tp = row - 256, pos = (wc & 1) ? (tp & 63) : (tp >> 6);
                                const f32x4 cs0 = *(const f32x4*)(rope + (pos * 16 + 4 * fq) * 2), cs1 = *(const f32x4*)(rope + (pos * 16 + 4 * fq + 2) * 2);
                                f32x4 w0, w1;
                                w0[0] = v0[0] * cs0[0] - v0[1] * cs0[1]; w0[1] = v0[1] * cs0[0] + v0[0] * cs0[1];
                                w0[2] = v0[2] * cs0[2] - v0[3] * cs0[3]; w0[3] = v0[3] * cs0[2] + v0[2] * cs0[3];
                                w1[0] = v1[0] * cs1[0] - v1[1] * cs1[1]; w1[1] = v1[1] * cs1[0] + v1[0] * cs1[1];
                                w1[2] = v1[2] * cs1[2] - v1[3] * cs1[3]; w1[3] = v1[3] * cs1[2] + v1[2] * cs1[3];
                                v0 = w0; v1 = w1;
                            }
                            bf16_t* dst;
                            if (u.pn < 4) { v0 = v0 * QSCALE1; v1 = v1 * QSCALE1; dst = q + (size_t)row * 1024 + gc; }
                            else dst = k + (size_t)row * 1024 + (gc - 1024);
                            u32x4 w; w.x = pk2(v0[0], v0[1]); w.y = pk2(v0[2], v0[3]); w.z = pk2(v1[0], v1[1]); w.w = pk2(v1[2], v1[3]);
                            *(u32x4*)dst = w;
                        }
                    }
                }
        }
#endif
#ifdef TRIVIAL_EPI
        for (int ai = 0; ai < 2; ++ai) for (int bj = 0; bj < 2; ++bj) for (int m = 0; m < 4; ++m) for (int n = 0; n < 2; ++n) *(f32x4*)(xd_x + (size_t)(u.pm * 256 + ai * 128 + wr * 64 + m * 16 + fr) * 1024 + u.pn * 256 + bj * 128 + colt + 4 * n) = acc[ai][bj][m][n];
#endif
    }
};

DI int map_src_col(int map, int j) {
    if (map == 1) { const int t = j >> 8, w = j & 255; return w < 128 ? 128 * t + w : DFF + 128 * t + (w - 128); }
    if (map == 2) { const int p = j & 63, a = p >> 5, rem = p & 31, f = rem >> 1, hh = rem & 1; return (j & ~63) + a * 32 + hh * 16 + f; }
    return j;
}
DI void transpose_item(const Piece& P, LAS float* scr, int item, int lane) {
    const int nblk = P.nrows / 32, kb = item / nblk, nb = item % nblk, k0 = 64 * kb, n0 = 32 * nb;
    const int sc = map_src_col(P.map, n0 + (lane & 31));
#pragma unroll 32
    for (int i = 0; i < 32; ++i) { const int kk = 2 * i + (lane >> 5); scr[kk * 33 + (lane & 31)] = __builtin_nontemporal_load(P.src + (size_t)(k0 + kk) * P.Nsrc + sc); }
    asm volatile("s_waitcnt lgkmcnt(0)" ::: "memory");
    const int c = lane & 7;
#pragma unroll
    for (int j = 0; j < 4; ++j) { const int n = (lane >> 3) + 8 * j; const LAS float* s = scr + (8 * c) * 33 + n;
        u32x4 o; o.x = pk2(s[0 * 33], s[1 * 33]); o.y = pk2(s[2 * 33], s[3 * 33]); o.z = pk2(s[4 * 33], s[5 * 33]); o.w = pk2(s[6 * 33], s[7 * 33]);
        *(u32x4*)(P.dst + (size_t)(n0 + n) * P.K + k0 + 8 * c) = o; }
    asm volatile("s_waitcnt lgkmcnt(0)" ::: "memory");
}

DI void phase_p0a(const Params& P, LAS unsigned char* lds, float* misc) {
    int tid_ = threadIdx.x; asm volatile("" : "+v"(tid_)); const int tid = tid_, lane = tid & 63, w = tid >> 6, G = gridDim.x;
    const int gtid = blockIdx.x * 512 + tid, NT = G * 512;
    {
        LAS float* red = (LAS float*)lds;
        const float* c = P.in[1]; const float* cc = P.in[3];
        for (int it = blockIdx.x; it < 192; it += G) {
            const int l = it / 96, n = (it % 96) * 64 + lane;
            const float* W = P.in[4] + (size_t)l * D * 6144;
            float ax = 0.f, ac = 0.f;
#pragma unroll 32
            for (int kk = 0; kk < 128; ++kk) { const int k = w * 128 + kk; const float wv = __builtin_nontemporal_load(W + (size_t)k * 6144 + n); ax += silu_f(c[k]) * wv; ac += silu_f(cc[k]) * wv; }
            __syncthreads();
            red[(w * 64 + lane) * 2] = ax; red[(w * 64 + lane) * 2 + 1] = ac;
            __syncthreads();
            if (w == 0) { float sx = 0.f, sc = 0.f;
#pragma unroll
                for (int i = 0; i < 8; ++i) { sx += red[(i * 64 + lane) * 2]; sc += red[(i * 64 + lane) * 2 + 1]; }
                const float b = P.in[5][l * 6144 + n];
                misc[OFF_MOD + (l * 2 + 0) * 6144 + n] = sx + b; misc[OFF_MOD + (l * 2 + 1) * 6144 + n] = sc + b; }
        }
        __syncthreads();
    }
    {
        LAS float* scr = (LAS float*)(lds + w * 16384);
        const int gw = blockIdx.x * 8 + w, NGW = G * 8;
        int total = 0;
#pragma unroll 1
        for (int p = 0; p < 13; ++p) total += (P.pc[p].K / 64) * (P.pc[p].nrows / 32);
        for (int it = gw; it < total; it += NGW) {
            int r = it, p = 0;
#pragma unroll 1
            for (; p < 12; ++p) { const int cnt = (P.pc[p].K / 64) * (P.pc[p].nrows / 32); if (r < cnt) break; r -= cnt; }
            transpose_item(P.pc[p], scr, r, lane);
        }
    }
    {
        bf16_t* wp0 = (bf16_t*)(P.ws + W_P0);
        const float* wg1 = P.in[12];
        for (int e = gtid; e < 256 * 1024; e += NT) { const int row = e >> 10, k = e & 1023; float v = 0.f; if (row < 32) v = wg1[(row >> 4) * 16384 + k * 16 + (row & 15)];
            wp0[(size_t)(2048 + row) * 1024 + k] = (bf16_t)(pk2(v, 0.f) & 0xffff); }
    }
    if (gtid < 4096) { const int pos = gtid >> 4, f = gtid & 15; const float inv = powf(10000.f, -(float)f / 16.f); const float ang = (float)pos * inv;
        misc[OFF_ROPE + gtid * 2] = cosf(ang); misc[OFF_ROPE + gtid * 2 + 1] = sinf(ang); }
    if (gtid == 0) { float s1 = 0.f, s2 = 0.f; for (int i = 0; i < 64; ++i) { s1 += P.in[20][i] * P.in[21][i]; s2 += P.in[22][i] * P.in[23][i]; }
        misc[OFF_LAM] = expf(s1) - expf(s2) + LAMBDA_INIT; }
    for (int e = gtid; e < 4 * MT; e += NT) misc[OFF_SS + MT + e] = 0.f;
}

DI void phase_p0b(const Params& P, float* misc) {
    int tid_ = threadIdx.x; asm volatile("" : "+v"(tid_)); const int tid = tid_, lane = tid & 63, w = tid >> 6, G = gridDim.x;
    const int gtid = blockIdx.x * 512 + tid, NT = G * 512, gw = blockIdx.x * 8 + w, NGW = G * 8;
    for (int e = gtid; e < 8192; e += NT) { const int c = e & 1023, path = (e >> 10) & 1, s = (e >> 11) & 1, l = e >> 12;
        const float nv = (s ? P.in[7] : P.in[6])[l * D + c]; misc[OFF_GS + e] = nv * (1.f + misc[OFF_MOD + (l * 2 + path) * 6144 + (s ? 4 : 1) * 1024 + c]); }
    bf16_t* act0 = (bf16_t*)(P.ws + WS_ACT0 + ACT0_PAD);
    for (int row = gw; row < MT; row += NGW) {
        const int path = row < 256; const float* src = path ? P.in[2] + (size_t)row * D : P.in[0] + (size_t)(row - 256) * D;
        const float* sc = misc + OFF_MOD + (0 * 2 + path) * 6144 + 1024; const float* nm = P.in[6];
        float s = 0.f;
#pragma unroll
        for (int j = 0; j < 4; ++j) { const int c = 4 * lane + 256 * j; const f32x4 v = __builtin_nontemporal_load((const f32x4*)(src + c)); const f32x4 g4 = *(const f32x4*)(nm + c) * (*(const f32x4*)(sc + c) + 1.f);
            s += (v[0] * v[0] + v[1] * v[1]) + (v[2] * v[2] + v[3] * v[3]); const f32x4 a = v * g4; u32x2 o; o.x = pk2(a[0], a[1]); o.y = pk2(a[2], a[3]); *(u32x2*)(act0 + (size_t)row * D + c) = o;
            u32x2 xr; xr.x = pk2(v[0], v[1]); xr.y = pk2(v[2], v[3]); *(u32x2*)((bf16_t*)(P.ws + WS_XR) + (size_t)row * D + c) = xr; }
        s = wave_sum(s);
        if (lane == 0) misc[OFF_SS + row] = s;
    }
    for (int it = gw; it < 17664; it += NGW) {
        int j = it; const bf16_t* Wt; int boff, nb, l, sh;
        if (j < 2304) { Wt = (const bf16_t*)(P.ws + W_P0); boff = B_P0; nb = 2304; l = 0; sh = 0; }
        else if ((j -= 2304) < 1024) { Wt = (const bf16_t*)(P.ws + W_V0); boff = B_V0; nb = 1024; l = 0; sh = 0; }
        else if ((j -= 1024) < 5632) { Wt = (const bf16_t*)(P.ws + W_UP0); boff = B_UP0; nb = 5632; l = 0; sh = 3; }
        else if ((j -= 5632) < 2048) { Wt = (const bf16_t*)(P.ws + W_QK1); boff = B_QK1; nb = 2048; l = 1; sh = 0; }
        else if ((j -= 2048) < 1024) { Wt = (const bf16_t*)(P.ws + W_V1); boff = B_V1; nb = 1024; l = 1; sh = 0; }
        else { j -= 1024; Wt = (const bf16_t*)(P.ws + W_UP1); boff = B_UP1; nb = 5632; l = 1; sh = 3; }
        const float* s0 = misc + OFF_MOD + (l * 2 + 0) * 6144 + sh * 1024; const float* s1 = misc + OFF_MOD + (l * 2 + 1) * 6144 + sh * 1024;
        float a0 = 0.f, a1 = 0.f;
#pragma unroll
        for (int i = 0; i < 2; ++i) { const int k = 8 * lane + 512 * i; const u32x4 wv = *(const u32x4*)(Wt + (size_t)j * 1024 + k);
            const f32x4 x0 = *(const f32x4*)(s0 + k), x1 = *(const f32x4*)(s0 + k + 4), y0 = *(const f32x4*)(s1 + k), y1 = *(const f32x4*)(s1 + k + 4);
            const float w0 = bflo(wv.x), w1 = bfhi(wv.x), w2 = bflo(wv.y), w3 = bfhi(wv.y), w4 = bflo(wv.z), w5 = bfhi(wv.z), w6 = bflo(wv.w), w7 = bfhi(wv.w);
            a0 += x0[0] * w0 + x0[1] * w1 + x0[2] * w2 + x0[3] * w3 + x1[0] * w4 + x1[1] * w5 + x1[2] * w6 + x1[3] * w7;
            a1 += y0[0] * w0 + y0[1] * w1 + y0[2] * w2 + y0[3] * w3 + y1[0] * w4 + y1[1] * w5 + y1[2] * w6 + y1[3] * w7; }
        a0 = wave_sum(a0); a1 = wave_sum(a1);
        if (lane == 0) { misc[OFF_BIAS + boff + j] = a0; misc[OFF_BIAS + boff + nb + j] = a1; }
    }
}

constexpr int GL_LQ = 0, GL_LK = 17408, GL_LKT = 34816, GL_LSC = 53248, GL_LA = 62464, GL_LGT = 62976, GL_LT = 65024 + 2048, GL_LO = 0;
static_assert(GL_LGT >= 62464 + 512 && GL_LT >= 66560, "gla lds");
DI float logsig(float x) { return fminf(x, 0.f) - __logf(1.f + __expf(-fabsf(x))); }

DI void gla_sweep(const Params& P, LAS unsigned char* lds, float* misc, int seg, int h, int d, int outmode) {
    int tid_ = threadIdx.x; asm volatile("" : "+v"(tid_)); const int tid = tid_, lane = tid & 63, w = __builtin_amdgcn_readfirstlane(tid >> 6), l31 = lane & 31, hh = lane >> 5, l15 = lane & 15, l4 = lane >> 4;
    const int p0 = (260 * seg) / NSEG, nch = (260 * (seg + 1)) / NSEG - p0;
    const int oidx = seg;
    const int dk = tid & 127, tg = tid >> 7;
    const bf16_t* Q0 = (const bf16_t*)(P.ws + R_Q0); const bf16_t* K0 = (const bf16_t*)(P.ws + R_K0); const bf16_t* R0 = (const bf16_t*)(P.ws + R_R0);
    const bf16_t* Vt = (const bf16_t*)(P.ws + R_VT); const float* T0 = (const float*)(P.ws + R_T0);
    bf16_t* odst = d == 0 ? (bf16_t*)(P.ws + WS_ACT1) : (bf16_t*)P.out;
    float* SB = (float*)(P.ws + WS_SB) + (size_t)(oidx * 8 + h * 2 + d) * 32768;
    LAS bf16_t* LQ = (LAS bf16_t*)(lds + GL_LQ); LAS bf16_t* LK = (LAS bf16_t*)(lds + GL_LK); LAS bf16_t* LKT = (LAS bf16_t*)(lds + GL_LKT); LAS bf16_t* LSC = (LAS bf16_t*)(lds + GL_LSC);
    LAS float* LA = (LAS float*)(lds + GL_LA); LAS float* LGT = (LAS float*)(lds + GL_LGT); LAS float* LT = (LAS float*)(lds + GL_LT); LAS float* LO = (LAS float*)(lds + GL_LO);
    float w2[16];
#pragma unroll
    for (int r = 0; r < 16; ++r) w2[r] = P.in[13][(d * 16 + r) * 512 + h * 128 + dk];
    const float bgv = P.in[14][d * 512 + h * 128 + dk];
    f32x16 S[4];
#pragma unroll
    for (int jt = 0; jt < 4; ++jt)
#pragma unroll
        for (int r = 0; r < 16; ++r) S[jt][r] = outmode == 0 ? 0.f : SB[(32 * jt + crow(r, hh)) * 256 + 32 * w + l31];
    float logA = 0.f;
    f32x4 tpre = {0.f, 0.f, 0.f, 0.f};
    { const int c_ = d == 0 ? p0 : (p0 < 4 ? 3 - p0 : 263 - p0); if (tid < 256) tpre = *(const f32x4*)(T0 + (size_t)(64 * c_ + (tid >> 2)) * 32 + 16 * d + 4 * (tid & 3)); }
    for (int ci = 0; ci < nch; ++ci) {
        const int pp = p0 + ci; const int c = d == 0 ? pp : (pp < 4 ? 3 - pp : 263 - pp); const int tok0 = 64 * c;
        bf16x8 vf[4];
#pragma unroll
        for (int kk = 0; kk < 4; ++kk) vf[kk] = *(const bf16x8*)(Vt + (size_t)(h * 256 + 32 * w + l31) * MT + tok0 + 16 * kk + 8 * hh);
        unsigned kraw[16], qraw[16];
#pragma unroll
        for (int i = 0; i < 16; ++i) { const size_t o_ = (size_t)(tok0 + 16 * tg + i) * 512 + h * 128 + dk; kraw[i] = K0[o_]; qraw[i] = outmode ? (unsigned)Q0[o_] : 0u; }
        __syncthreads();
        if (tid < 256) *(LAS f32x4*)(LT + (tid >> 2) * 16 + 4 * (tid & 3)) = tpre;
        __syncthreads();
        if (ci + 1 < nch && tid < 256) { const int pn = pp + 1; const int cn = d == 0 ? pn : (pn < 4 ? 3 - pn : 263 - pn); tpre = *(const f32x4*)(T0 + (size_t)(64 * cn + (tid >> 2)) * 32 + 16 * d + 4 * (tid & 3)); }
        float b[16];
#pragma unroll
        for (int i = 0; i < 16; ++i) { float pre = bgv;
#pragma unroll
            for (int r4 = 0; r4 < 4; ++r4) { const f32x4 tv = *(const LAS f32x4*)(LT + (16 * tg + i) * 16 + 4 * r4); pre += tv[0] * w2[4 * r4] + tv[1] * w2[4 * r4 + 1] + tv[2] * w2[4 * r4 + 2] + tv[3] * w2[4 * r4 + 3]; }
            b[i] = logsig(pre) * (1.f / 16.f); }
        if (d == 0) {
#pragma unroll
            for (int i = 1; i < 16; ++i) b[i] += b[i - 1];
            LGT[tg * 128 + dk] = b[15];
        } else {
#pragma unroll
            for (int i = 14; i >= 0; --i) b[i] += b[i + 1];
            LGT[tg * 128 + dk] = b[0];
        }
        __syncthreads();
        const float g0 = LGT[dk], g1 = LGT[128 + dk], g2 = LGT[256 + dk], g3 = LGT[384 + dk];
        const float btot = (g0 + g1) + (g2 + g3);
        float off;
        if (d == 0) off = (tg > 0 ? g0 : 0.f) + (tg > 1 ? g1 : 0.f) + (tg > 2 ? g2 : 0.f);
        else off = (tg < 1 ? g1 : 0.f) + (tg < 2 ? g2 : 0.f) + (tg < 3 ? g3 : 0.f);
        if (tg == 0) LA[dk] = __expf(btot);
        logA += btot;
        unsigned ktp[8];
#pragma unroll
        for (int i = 0; i < 16; i += 2) {
            const float b0 = b[i] + off, b1 = b[i + 1] + off;
            const float k0 = __uint_as_float(kraw[i] << 16), k1 = __uint_as_float(kraw[i + 1] << 16);
            ktp[i >> 1] = pk2(k0 * __expf(btot - b0), k1 * __expf(btot - b1));
            if (outmode) {
                const float q0 = __uint_as_float(qraw[i] << 16), q1 = __uint_as_float(qraw[i + 1] << 16);
                LQ[(16 * tg + i) * 136 + dk] = (bf16_t)(pk2(q0 * __expf(b0), 0.f) & 0xffff); LQ[(16 * tg + i + 1) * 136 + dk] = (bf16_t)(pk2(q1 * __expf(b1), 0.f) & 0xffff);
                LK[(16 * tg + i) * 136 + dk] = (bf16_t)(pk2(k0 * __expf(-b0), 0.f) & 0xffff); LK[(16 * tg + i + 1) * 136 + dk] = (bf16_t)(pk2(k1 * __expf(-b1), 0.f) & 0xffff);
            }
        }
        *(LAS u32x4*)(LKT + dk * 72 + 16 * tg) = (u32x4){ktp[0], ktp[1], ktp[2], ktp[3]};
        *(LAS u32x4*)(LKT + dk * 72 + 16 * tg + 8) = (u32x4){ktp[4], ktp[5], ktp[6], ktp[7]};
        __syncthreads();
        f32x16 o[2];
        if (outmode) {
            const int ti = w >> 1;
#pragma unroll
            for (int sj = 0; sj < 2; ++sj) { const int si = 2 * (w & 1) + sj; f32x4 a4 = {0.f, 0.f, 0.f, 0.f};
#pragma unroll
                for (int kk = 0; kk < 4; ++kk) { const bf16x8 fa = *(const LAS bf16x8*)(LK + (16 * si + l15) * 136 + 32 * kk + 8 * l4), fb = *(const LAS bf16x8*)(LQ + (16 * ti + l15) * 136 + 32 * kk + 8 * l4);
                    a4 = __builtin_amdgcn_mfma_f32_16x16x32_bf16(fa, fb, a4, 0, 0, 0); }
                const int t = 16 * ti + l15, s0 = 16 * si + 4 * l4;
#pragma unroll
                for (int r = 0; r < 4; ++r) { const int s = s0 + r; const bool keep = d == 0 ? (s <= t) : (s >= t); if (!keep) a4[r] = 0.f; }
                *(LAS u32x2*)(LSC + t * 72 + s0) = (u32x2){pk2(a4[0], a4[1]), pk2(a4[2], a4[3])}; }
            __syncthreads();
#pragma unroll
            for (int tt = 0; tt < 2; ++tt) {
                f32x16 oo;
#pragma unroll
                for (int r = 0; r < 16; ++r) oo[r] = 0.f;
#pragma unroll
                for (int kk = 0; kk < 4; ++kk) { const bf16x8 fa = *(const LAS bf16x8*)(LSC + (32 * tt + l31) * 72 + 16 * kk + 8 * hh); oo = __builtin_amdgcn_mfma_f32_32x32x16_bf16(fa, vf[kk], oo, 0, 0, 0); }
#pragma unroll
                for (int jt = 0; jt < 4; ++jt)
#pragma unroll
                    for (int s2 = 0; s2 < 2; ++s2) {
                        const u32x4 pb = {pk2(S[jt][8 * s2], S[jt][8 * s2 + 1]), pk2(S[jt][8 * s2 + 2], S[jt][8 * s2 + 3]), pk2(S[jt][8 * s2 + 4], S[jt][8 * s2 + 5]), pk2(S[jt][8 * s2 + 6], S[jt][8 * s2 + 7])};
                        const u32x2 alo = *(const LAS u32x2*)(LQ + (32 * tt + l31) * 136 + 32 * jt + 16 * s2 + 4 * hh), ahi = *(const LAS u32x2*)(LQ + (32 * tt + l31) * 136 + 32 * jt + 16 * s2 + 8 + 4 * hh);
                        const u32x4 pa = {alo.x, alo.y, ahi.x, ahi.y};
                        oo = __builtin_amdgcn_mfma_f32_32x32x16_bf16(__builtin_bit_cast(bf16x8, pa), __builtin_bit_cast(bf16x8, pb), oo, 0, 0, 0);
                    }
                o[tt] = oo;
            }
        }
#pragma unroll
        for (int jt = 0; jt < 4; ++jt) {
#pragma unroll
            for (int r = 0; r < 16; ++r) S[jt][r] *= LA[32 * jt + crow(r, hh)];
#pragma unroll
            for (int kk = 0; kk < 4; ++kk) { const bf16x8 fa = *(const LAS bf16x8*)(LKT + (32 * jt + l31) * 72 + 16 * kk + 8 * hh); S[jt] = __builtin_amdgcn_mfma_f32_32x32x16_bf16(fa, vf[kk], S[jt], 0, 0, 0); }
        }
        if (outmode == 1) {
#pragma unroll
            for (int tt = 0; tt < 2; ++tt)
#pragma unroll
                for (int r = 0; r < 16; ++r) __builtin_nontemporal_store((bf16_t)(pk2(o[tt][r], 0.f) & 0xffff), odst + (size_t)(tok0 + 32 * tt + crow(r, hh)) * D + h * 256 + 32 * w + l31);
        }
    }
    if (outmode == 0) {
#pragma unroll
        for (int jt = 0; jt < 4; ++jt)
#pragma unroll
            for (int r = 0; r < 16; ++r) SB[(32 * jt + crow(r, hh)) * 256 + 32 * w + l31] = S[jt][r];
        if (tg == 0) misc[OFF_ASEG + (oidx * 8 + h * 2 + d) * 128 + dk] = __expf(logA);
    }
    __syncthreads();
}

DI void phase_gla_readout(const Params& P) {
    int tid_ = threadIdx.x; asm volatile("" : "+v"(tid_)); const int lane = tid_ & 63, gw = blockIdx.x * 8 + (tid_ >> 6), NGW = gridDim.x * 8;
    bf16_t* act1 = (bf16_t*)(P.ws + WS_ACT1); const bf16_t* ob = (const bf16_t*)P.out; const bf16_t* R0 = (const bf16_t*)(P.ws + R_R0);
    const f32x4 gn = *(const f32x4*)(P.in[15] + 4 * lane);
    for (int it0 = gw; it0 < MT * 4; it0 += 4 * NGW) {
        u32x2 a[4], b[4], r[4]; size_t off[4];
#pragma unroll
        for (int j = 0; j < 4; ++j) { const int it = it0 + j * NGW; const int itc = it < MT * 4 ? it : it0; off[j] = (size_t)(itc >> 2) * D + (itc & 3) * 256 + 4 * lane;
            a[j] = __builtin_nontemporal_load((const u32x2*)(act1 + off[j])); b[j] = __builtin_nontemporal_load((const u32x2*)(ob + off[j])); r[j] = __builtin_nontemporal_load((const u32x2*)(R0 + off[j])); }
#pragma unroll
        for (int j = 0; j < 4; ++j) {
            const float o0 = bflo(a[j].x) + bflo(b[j].x), o1 = bfhi(a[j].x) + bfhi(b[j].x), o2 = bflo(a[j].y) + bflo(b[j].y), o3 = bfhi(a[j].y) + bfhi(b[j].y);
            const float sq = wave_sum((o0 * o0 + o1 * o1) + (o2 * o2 + o3 * o3));
            const float rstd = __builtin_amdgcn_rsqf(sq * (1.f / 256.f) + EPS);
            u32x2 w; w.x = pk2(o0 * rstd * gn[0] * bflo(r[j].x), o1 * rstd * gn[1] * bfhi(r[j].x)); w.y = pk2(o2 * rstd * gn[2] * bflo(r[j].y), o3 * rstd * gn[3] * bfhi(r[j].y));
            if (it0 + j * NGW < MT * 4) *(u32x2*)(act1 + off[j]) = w;
        }
    }
}

DI void phase_gla_combine(const Params& P, float* misc) {
    int tid_ = threadIdx.x; asm volatile("" : "+v"(tid_));
    const int gid = blockIdx.x * 512 + tid_;
    for (int e2 = gid; e2 < 131072; e2 += gridDim.x * 512) {
        const int e = 2 * e2, hd = e >> 15, idx = e & 32767, dk = idx >> 8;
        float* base = (float*)(P.ws + WS_SB) + (size_t)hd * 32768 + idx;
        f32x2 run = {0.f, 0.f};
#pragma unroll 11
        for (int o = 0; o < NSEG; ++o) { f32x2* p = (f32x2*)(base + (size_t)o * 8 * 32768); const f32x2 tmp = *p; *p = run; const float a = misc[OFF_ASEG + (o * 8 + hd) * 128 + dk]; run = run * a + tmp; }
    }
}

constexpr int AT_BUF = 36864, AT_V = 17408;
constexpr float AT_THR = 8.0f;
DI void attn_unit(const Params& P, LAS unsigned char* lds, const float* misc, int h, int qb) {
    int tid_ = threadIdx.x; asm volatile("" : "+v"(tid_)); const int tid = tid_, lane = tid & 63, w = __builtin_amdgcn_readfirstlane(tid >> 6), l31 = lane & 31, hh = lane >> 5;
    const int ns = w >> 2, qrow0 = 256 + qb * 128 + 32 * (w & 3);
    const bf16_t* Q1 = (const bf16_t*)(P.ws + R_Q1); const bf16_t* K1 = (const bf16_t*)(P.ws + R_K1); const bf16_t* Vt = (const bf16_t*)(P.ws + R_VT);
    bf16_t* act1 = (bf16_t*)(P.ws + WS_ACT1);
    bf16x8 qf[4];
#pragma unroll
    for (int kk = 0; kk < 4; ++kk) qf[kk] = *(const bf16x8*)(Q1 + (size_t)(qrow0 + l31) * D + h * 128 + ns * 64 + 16 * kk + 8 * hh);
    LAS unsigned char* qlds = lds + 3 * AT_BUF + w * 4096 + lane * 16;
#pragma unroll
    for (int kk = 0; kk < 4; ++kk) *(LAS bf16x8*)(qlds + kk * 1024) = qf[kk];
    f32x16 o[4];
#pragma unroll
    for (int jt = 0; jt < 4; ++jt)
#pragma unroll
        for (int r = 0; r < 16; ++r) o[jt][r] = 0.f;
    float mrun = 0.f, lsum = 0.f;
    const int krow = tid >> 4, kc = tid & 15, vrow = tid >> 2, vc = tid & 3;
    const unsigned koff = (unsigned)(krow * D + h * 128 + 8 * kc), voff = (unsigned)((h * 128 + vrow) * MT + 16 * vc);
    u32x4 kreg[2], vreg[2];
    constexpr int NT = MT / 64;
#define AT_LOAD(t) do { const bf16_t* kb_ = K1 + (size_t)(64 * (t)) * D; const bf16_t* vb_ = Vt + 64 * (t); kreg[0] = *(const u32x4*)(kb_ + koff); kreg[1] = *(const u32x4*)(kb_ + 32 * D + koff); \
        vreg[0] = *(const u32x4*)(vb_ + voff); vreg[1] = *(const u32x4*)(vb_ + 8 + voff); } while (0)
#define AT_STORE(b) do { *(LAS u32x4*)(lds + (b) * AT_BUF + krow * 272 + kc * 16) = kreg[0]; *(LAS u32x4*)(lds + (b) * AT_BUF + (krow + 32) * 272 + kc * 16) = kreg[1]; \
        *(LAS u32x4*)(lds + (b) * AT_BUF + AT_V + vrow * 144 + vc * 32) = vreg[0]; *(LAS u32x4*)(lds + (b) * AT_BUF + AT_V + vrow * 144 + vc * 32 + 16) = vreg[1]; } while (0)
#define AT_QK(dst, b) do { LAS unsigned char* kb_ = lds + (b) * AT_BUF; _Pragma("unroll") for (int kt = 0; kt < 2; ++kt) { f32x16 a_; _Pragma("unroll") for (int r = 0; r < 16; ++r) a_[r] = 0.f; \
        _Pragma("unroll") for (int kk = 0; kk < 4; ++kk) { const bf16x8 fa = *(const LAS bf16x8*)(kb_ + (32 * kt + l31) * 272 + (ns * 64 + 16 * kk + 8 * hh) * 2); a_ = __builtin_amdgcn_mfma_f32_32x32x16_bf16(fa, qf[kk], a_, 0, 0, 0); } \
        dst[kt] = a_; } } while (0)
    AT_LOAD(0); AT_STORE(0); AT_LOAD(1); AT_STORE(1);
    __syncthreads();
    f32x16 s[2], sn[2];
    AT_QK(s, 0);
    AT_LOAD(2);
    int bv = 0, bk = 1, bw = 2;
    const u32x4 ones4 = {0x3F803F80u, 0x3F803F80u, 0x3F803F80u, 0x3F803F80u};
    u32x4 nf = {0u, 0u, 0u, 0u};
#define AT_STEP(S, SN, t) do { \
        if ((t) + 2 < NT) AT_STORE(bw); \
        if ((t) + 3 < NT) AT_LOAD((t) + 3); \
        float mx = fmaxf(fmaxf(S[0][0], S[0][1]), S[0][2]); \
        _Pragma("unroll") for (int r = 3; r < 15; r += 2) mx = fmaxf(fmaxf(mx, S[0][r]), S[0][r + 1]); \
        mx = fmaxf(mx, S[0][15]); \
        _Pragma("unroll") for (int r = 0; r < 16; r += 2) mx = fmaxf(fmaxf(mx, S[1][r]), S[1][r + 1]); \
        mx = fmaxf(mx, __shfl_xor(mx, 32)); \
        if ((t) == 0 || __builtin_amdgcn_ballot_w64(mx > AT_THR) != 0ull) { \
            const float want = mrun + (((t) == 0 || mx > AT_THR) ? mx : 0.f); \
            const float nref = __uint_as_float((__float_as_uint(want) + 0x8000u) & 0xffff0000u);     \
            const float delta = nref - mrun; mrun = nref; \
            const float alpha = __builtin_amdgcn_exp2f(-delta); \
            _Pragma("unroll") for (int kt = 0; kt < 2; ++kt) _Pragma("unroll") for (int r = 0; r < 16; ++r) S[kt][r] -= delta; \
            _Pragma("unroll") for (int jt = 0; jt < 4; ++jt) _Pragma("unroll") for (int r = 0; r < 16; ++r) o[jt][r] *= alpha; \
            lsum *= alpha; \
            nf.x = hh == 0 ? (__float_as_uint(-mrun) >> 16) : 0u; \
        } \
        LAS unsigned char* kb = lds + bk * AT_BUF; LAS unsigned char* vb = lds + bv * AT_BUF + AT_V; \
        bf16x8 kf[4], vf0[4], qv[4]; \
        { LAS unsigned char* qa_ = qlds; asm volatile("" : "+v"(qa_)); _Pragma("unroll") for (int kk = 0; kk < 4; ++kk) qv[kk] = *(const LAS bf16x8*)(qa_ + kk * 1024); } \
        f32x16 zero16; \
        _Pragma("unroll") for (int r = 0; r < 16; ++r) zero16[r] = 0.f; \
        _Pragma("unroll") for (int i = 0; i < 4; ++i) kf[i] = *(const LAS bf16x8*)(kb + l31 * 272 + (ns * 64 + 16 * i + 8 * hh) * 2); \
        __builtin_amdgcn_sched_barrier(0); \
        SN[0] = __builtin_amdgcn_mfma_f32_32x32x16_bf16(__builtin_bit_cast(bf16x8, ones4), __builtin_bit_cast(bf16x8, nf), zero16, 0, 0, 0); \
        _Pragma("unroll") for (int kk = 0; kk < 4; ++kk) SN[0] = __builtin_amdgcn_mfma_f32_32x32x16_bf16(kf[kk], qv[kk], SN[0], 0, 0, 0); \
        _Pragma("unroll") for (int i = 0; i < 4; ++i) kf[i] = *(const LAS bf16x8*)(kb + (32 + l31) * 272 + (ns * 64 + 16 * i + 8 * hh) * 2); \
        SN[1] = __builtin_amdgcn_mfma_f32_32x32x16_bf16(__builtin_bit_cast(bf16x8, ones4), __builtin_bit_cast(bf16x8, nf), zero16, 0, 0, 0); \
        _Pragma("unroll") for (int kk = 0; kk < 4; ++kk) SN[1] = __builtin_amdgcn_mfma_f32_32x32x16_bf16(kf[kk], qv[kk], SN[1], 0, 0, 0); \
        _Pragma("unroll") for (int jt = 0; jt < 4; ++jt) vf0[jt] = *(const LAS bf16x8*)(vb + (32 * jt + l31) * 144 + 8 * hh * 2); \
        float ps0 = 0.f, ps1 = 0.f; \
        _Pragma("unroll") for (int kt = 0; kt < 2; ++kt) _Pragma("unroll") for (int r = 0; r < 16; r += 2) { const float p0 = __builtin_amdgcn_exp2f(S[kt][r]), p1 = __builtin_amdgcn_exp2f(S[kt][r + 1]); S[kt][r] = p0; S[kt][r + 1] = p1; ps0 += p0; ps1 += p1; } \
        lsum += ps0 + ps1; \
        __builtin_amdgcn_sched_barrier(0); \
        AT_PV(S, 0); AT_PV(S, 1); AT_PV(S, 2); AT_PV(S, 3); \
        { const int tmp = bv; bv = bk; bk = bw; bw = tmp; } \
        __syncthreads(); } while (0)
#define AT_PV(S, step) do { const int kt_ = (step) >> 1, s2_ = (step) & 1; \
            const u32x4 pb = {pk2(S[kt_][8 * s2_], S[kt_][8 * s2_ + 1]), pk2(S[kt_][8 * s2_ + 2], S[kt_][8 * s2_ + 3]), pk2(S[kt_][8 * s2_ + 4], S[kt_][8 * s2_ + 5]), pk2(S[kt_][8 * s2_ + 6], S[kt_][8 * s2_ + 7])}; \
            _Pragma("unroll") for (int jt = 0; jt < 4; ++jt) o[jt] = __builtin_amdgcn_mfma_f32_32x32x16_bf16(vf0[jt], __builtin_bit_cast(bf16x8, pb), o[jt], 0, 0, 0); \
            if ((step) < 3) { _Pragma("unroll") for (int jt = 0; jt < 4; ++jt) vf0[jt] = *(const LAS bf16x8*)(vb + (32 * jt + l31) * 144 + (16 * ((step) + 1) + 8 * hh) * 2); } \
            __builtin_amdgcn_sched_barrier(0); } while (0)
    static_assert(NT % 2 == 0, "ping-pong loop");
    for (int t = 0; t < NT; t += 2) { AT_STEP(s, sn, t); AT_STEP(sn, s, t + 1); }
#undef AT_STEP
#undef AT_PV
#undef AT_LOAD
#undef AT_STORE
#undef AT_QK
    const float ltot = lsum + __shfl_xor(lsum, 32);
    const float inv = 1.f / ltot;
    LAS float* XB = (LAS float*)lds;
    if (ns == 1) {
        const float f = inv * misc[OFF_LAM];
#pragma unroll
        for (int jt = 0; jt < 4; ++jt)
#pragma unroll
            for (int r = 0; r < 16; ++r) XB[(((w & 3) * 4 + jt) * 16 + r) * 64 + lane] = o[jt][r] * f;
    }
    __syncthreads();
    if (ns == 0) {
        float sq = 0.f;
#pragma unroll
        for (int jt = 0; jt < 4; ++jt)
#pragma unroll
            for (int r = 0; r < 16; ++r) { const float v = o[jt][r] * inv - XB[(((w & 3) * 4 + jt) * 16 + r) * 64 + lane]; o[jt][r] = v; sq += v * v; }
        sq += __shfl_xor(sq, 32);
        const float rstd = __builtin_amdgcn_rsqf(sq * (1.f / 128.f) + EPS) * (1.f - LAMBDA_INIT);
        const float* sub = P.in[24];
#pragma unroll
        for (int jt = 0; jt < 4; ++jt)
#pragma unroll
            for (int r4 = 0; r4 < 4; ++r4) {
                const int dv = 32 * jt + 8 * r4 + 4 * hh; const f32x4 g4 = *(const f32x4*)(sub + dv);
                u32x2 ow; ow.x = pk2(o[jt][4 * r4] * rstd * g4[0], o[jt][4 * r4 + 1] * rstd * g4[1]); ow.y = pk2(o[jt][4 * r4 + 2] * rstd * g4[2], o[jt][4 * r4 + 3] * rstd * g4[3]);
                *(u32x2*)(act1 + (size_t)(qrow0 + l31) * D + h * 128 + dv) = ow;
            }
    }
    __syncthreads();
}

typedef __attribute__((address_space(1))) unsigned gu32;
#define XB_TMO      128
#define XB_XCNT(j)  (256  + 64 * (j))
#define XB_XSUB(j)  (1280 + 64 * (j))
#define XB_XGEN(j)  (2304 + 64 * (j))
#define XB_TOP      3328
#define XB_TOPGEN   3392
#define XCD_BAR_WORDS 3456
#define XB_SPIN_CAP (1u << 18)

__device__ __forceinline__ unsigned xb_ld(unsigned* p)              { return __hip_atomic_load(p, __ATOMIC_RELAXED, __HIP_MEMORY_SCOPE_AGENT); }
__device__ __forceinline__ unsigned xb_add(unsigned* p, unsigned v) { return __hip_atomic_fetch_add(p, v, __ATOMIC_RELAXED, __HIP_MEMORY_SCOPE_AGENT); }
__device__ __forceinline__ unsigned xb_xcc_id() { return (unsigned)__builtin_amdgcn_s_getreg((3 << 11) | 20) & 0xFu; }
#define XB_SPIN(cond, bar) do { unsigned _sp = 0; while (cond) { __builtin_amdgcn_s_sleep(1); \
    if ((++_sp & 255u) == 0u) { if (xb_ld(&(bar)[XB_TMO])) break; if (_sp > XB_SPIN_CAP) { atomicAdd(&(bar)[XB_TMO], 1u); break; } } } } while (0)

struct XcdBarrier {
    unsigned* bar; unsigned x;
    volatile LAS unsigned* st;
};

__device__ __forceinline__ XcdBarrier xcd_barrier_post(unsigned* bar, volatile LAS unsigned* st) {
    XcdBarrier b; b.bar = bar; b.x = xb_xcc_id(); b.st = st;
    if (threadIdx.x == 0) (void)xb_add(&bar[XB_XCNT(b.x)], 1u);
    return b;
}
__device__ __forceinline__ void xcd_barrier_complete(unsigned* bar, unsigned x, unsigned& nloc, unsigned& nx) {
    const unsigned G = gridDim.x * gridDim.y * gridDim.z;
    unsigned sum, cnt, mine, sp = 0u;
    for (;;) {
        sum = 0u; cnt = 0u; mine = 0u;
#pragma unroll
        for (unsigned j = 0; j < 16; ++j) { const unsigned c = xb_ld(&bar[XB_XCNT(j)]); sum += c; cnt += (c > 0u) ? 1u : 0u; mine = (j == x) ? c : mine; }
        if (sum == G) break;
        __builtin_amdgcn_s_sleep(1);
        if ((++sp & 255u) == 0u) { if (xb_ld(&bar[XB_TMO])) break; if (sp > XB_SPIN_CAP) { atomicAdd(&bar[XB_TMO], 1u); break; } }
    }
    nloc = mine > 0u ? mine : 1u; nx = cnt > 0u ? cnt : 1u;
}

__device__ __forceinline__ void xcd_barrier(const XcdBarrier& b) {
    asm volatile("s_waitcnt vmcnt(0)" ::: "memory");
    __syncthreads();
    if (threadIdx.x == 0) {
        unsigned* bar = b.bar;
        __builtin_amdgcn_s_waitcnt(0);
        unsigned nloc = b.st[0], nx = b.st[1];
        if (nloc == 0u) { xcd_barrier_complete(bar, b.x, nloc, nx); b.st[0] = nloc; b.st[1] = nx; }
        const unsigned old = xb_add(&bar[XB_XSUB(b.x)], 1u);
        const unsigned gen = old / nloc;
        if (old + 1u == (gen + 1u) * nloc) {
            __builtin_amdgcn_fence(__ATOMIC_RELEASE, "agent");
            asm volatile("s_waitcnt vmcnt(0)" ::: "memory");
            const unsigned og = xb_add(&bar[XB_TOP], 1u);
            const unsigned tg = og / nx;
            if (og + 1u == (tg + 1u) * nx) xb_add(&bar[XB_TOPGEN], 1u);
            else XB_SPIN(xb_ld(&bar[XB_TOPGEN]) == tg, bar);
            __builtin_amdgcn_fence(__ATOMIC_ACQUIRE, "agent");
            xb_add(&bar[XB_XGEN(b.x)], 1u);
            asm volatile("s_waitcnt vmcnt(0)" ::: "memory");
        } else {
            XB_SPIN(xb_ld(&bar[XB_XGEN(b.x)]) == gen, bar);
            __builtin_amdgcn_fence(__ATOMIC_ACQUIRE, "agent");
            asm volatile("s_waitcnt vmcnt(0)" ::: "memory");
        }
    }
    __syncthreads();
}

#ifndef PHMASK
#define PHMASK 0xFFFF
#endif
#ifndef REP_ATTN
#define REP_ATTN 1
#endif
#ifndef REP_P4
#define REP_P4 1
#endif
#ifndef REP_P2
#define REP_P2 1
#endif
#ifndef REP_P0
#define REP_P0 1
#endif
__global__ void __launch_bounds__(512) fwd_megakernel(Params P) {
    extern __shared__ __attribute__((aligned(16))) unsigned char lds_raw[];
    LAS unsigned char* lds = (LAS unsigned char*)lds_raw;
    cg::grid_group grid = cg::this_grid();
    float* misc = (float*)(P.ws + WS_MISC);
    const int G = gridDim.x, bx = blockIdx.x;
    const char* act0 = (const char*)(P.ws + WS_ACT0 + ACT0_PAD); const char* act1 = (const char*)(P.ws + WS_ACT1);
    float* xc = (float*)(P.ws + WS_XC);
    volatile LAS unsigned* bst = (volatile LAS unsigned*)(lds + 147440);
    if (threadIdx.x < 2) bst[threadIdx.x] = 0u;
    __syncthreads();
    const XcdBarrier bar = xcd_barrier_post((unsigned*)(P.ws + WS_BAR), bst);

    if (PHMASK & 1) phase_p0a(P, lds, misc);
    grid.sync();
    if (PHMASK & 1) phase_p0b(P, misc);
    xcd_barrier(bar);

    Epi E; pg8::Sched S;
    E = Epi{}; E.mode = EM_PROJ0; E.ss = misc + OFF_SS; E.bias0 = misc + OFF_BIAS + B_P0; E.nb0 = 2304; E.bias1 = misc + OFF_BIAS + B_V0;
    E.q = (bf16_t*)(P.ws + R_Q0); E.k = (bf16_t*)(P.ws + R_K0); E.r = (bf16_t*)(P.ws + R_R0); E.vt = (bf16_t*)(P.ws + R_VT); E.t = (float*)(P.ws + R_T0);
    S = pg8::Sched{act0, (const char*)(P.ws + W_P0), (const char*)(P.ws + W_V0), act0, 65, 9, 0, 4, 65, 1024, 0, G, bx};
    if (PHMASK & 2) pg8::gemm_phase(lds, S, E);
    xcd_barrier(bar);
    if (PHMASK & 4) for (int rep = 0; rep < REP_P2; ++rep) for (int it = bx; it < NSEG * 8; it += G) gla_sweep(P, lds, misc, it >> 3, (it >> 1) & 3, it & 1, 0);
    xcd_barrier(bar);
    if (PHMASK & 4) phase_gla_combine(P, misc);
    xcd_barrier(bar);
    if (PHMASK & 8) for (int rep = 0; rep < REP_P4; ++rep) for (int it = bx; it < NSEG * 8; it += G) gla_sweep(P, lds, misc, it >> 3, (it >> 1) & 3, it & 1, 1);
    xcd_barrier(bar);
    if (PHMASK & 8) phase_gla_readout(P);
    xcd_barrier(bar);
    { constexpr int l = 0;
        if (l == 1) {
            E = Epi{}; E.mode = EM_QKV1; E.ss = misc + OFF_SS + 2 * MT; E.bias0 = misc + OFF_BIAS + B_QK1; E.nb0 = 2048; E.bias1 = misc + OFF_BIAS + B_V1;
            E.q = (bf16_t*)(P.ws + R_Q1); E.k = (bf16_t*)(P.ws + R_K1); E.vt = (bf16_t*)(P.ws + R_VT); E.rope = misc + OFF_ROPE;
            S = pg8::Sched{act0, (const char*)(P.ws + W_QK1), (const char*)(P.ws + W_V1), act0, 65, 8, 0, 4, 65, 1024, 0, G, bx};
            if (PHMASK & 2) pg8::gemm_phase(lds, S, E);
            xcd_barrier(bar);
            if (PHMASK & 16) for (int rep = 0; rep < REP_ATTN; ++rep) for (int u = __builtin_amdgcn_readfirstlane(bx); u < 1024; u = __builtin_amdgcn_readfirstlane(u + G)) attn_unit(P, lds, misc, u >> 7, u & 127);
            xcd_barrier(bar);
        }
        E = Epi{}; E.mode = EM_RES;
        E.xs_c = l == 0 ? P.in[2] : xc; E.xs_x = l == 0 ? P.in[0] : P.out; E.xd_c = xc; E.xd_x = P.out;
        E.xrb = (bf16_t*)(P.ws + WS_XR); E.src_f32 = 0; E.dst_f32 = 0;
        E.gate_c = misc + OFF_MOD + (l * 2 + 1) * 6144 + 2048; E.gate_x = misc + OFF_MOD + (l * 2 + 0) * 6144 + 2048;
        E.gs_c = misc + OFF_GS + ((l * 2 + 1) * 2 + 1) * 1024; E.gs_x = misc + OFF_GS + ((l * 2 + 1) * 2 + 0) * 1024;
        E.ss_out = misc + OFF_SS + (1 + 2 * l) * MT; E.act0 = (bf16_t*)act0;
        S = pg8::Sched{act1, (const char*)(P.ws + (l == 0 ? W_O0 : W_O1)), nullptr, nullptr, l == 0 ? 65 : 64, 4, l == 0 ? 0 : 1, 0, 0, 1024, 0, G, bx, 1};
        if (PHMASK & 2) pg8::gemm_phase(lds, S, E);
        xcd_barrier(bar);
        E = Epi{}; E.mode = EM_UP; E.ss = misc + OFF_SS + (1 + 2 * l) * MT; E.bias0 = misc + OFF_BIAS + (l == 0 ? B_UP0 : B_UP1); E.nb0 = NUP;
        E.conv = P.in[27] + (size_t)l * 3 * NUP; E.convb = P.in[28] + (size_t)l * NUP; E.g = (bf16_t*)(P.ws + R_G);
        S = pg8::Sched{act0, (const char*)(P.ws + (l == 0 ? W_UP0 : W_UP1)), nullptr, nullptr, l == 0 ? 69 : 67, 22, l == 0 ? 0 : 2, 0, 0, 1024, 1, G, bx};
        if (PHMASK & 2) pg8::gemm_phase(lds, S, E);
        xcd_barrier(bar);
        E = Epi{}; E.mode = EM_RES;
        E.xs_c = xc; E.xs_x = P.out; E.xd_c = xc; E.xd_x = P.out;
        E.xrb = (bf16_t*)(P.ws + WS_XR); E.src_f32 = 0; E.dst_f32 = 0;
        E.gate_c = misc + OFF_MOD + (l * 2 + 1) * 6144 + 5120; E.gate_x = misc + OFF_MOD + (l * 2 + 0) * 6144 + 5120;
        E.gs_c = l == 0 ? misc + OFF_GS + ((1 * 2 + 0) * 2 + 1) * 1024 : nullptr; E.gs_x = l == 0 ? misc + OFF_GS + ((1 * 2 + 0) * 2 + 0) * 1024 : nullptr;
        E.ss_out = misc + OFF_SS + (2 + 2 * l) * MT; E.act0 = (bf16_t*)act0;
        S = pg8::Sched{(const char*)(P.ws + R_G), (const char*)(P.ws + (l == 0 ? W_DN0 : W_DN1)), nullptr, nullptr, l == 0 ? 65 : 64, 4, l == 0 ? 0 : 1, 0, 0, DFF, 0, G, bx, 1};
        if (PHMASK & 2) pg8::gemm_phase(lds, S, E);
        xcd_barrier(bar);
    }
    { constexpr int l = 1;
        if (l == 1) {
            E = Epi{}; E.mode = EM_QKV1; E.ss = misc + OFF_SS + 2 * MT; E.bias0 = misc + OFF_BIAS + B_QK1; E.nb0 = 2048; E.bias1 = misc + OFF_BIAS + B_V1;
            E.q = (bf16_t*)(P.ws + R_Q1); E.k = (bf16_t*)(P.ws + R_K1); E.vt = (bf16_t*)(P.ws + R_VT); E.rope = misc + OFF_ROPE;
            S = pg8::Sched{act0, (const char*)(P.ws + W_QK1), (const char*)(P.ws + W_V1), act0, 65, 8, 0, 4, 65, 1024, 0, G, bx};
            if (PHMASK & 2) pg8::gemm_phase(lds, S, E);
            xcd_barrier(bar);
            if (PHMASK & 16) for (int rep = 0; rep < REP_ATTN; ++rep) for (int u = __builtin_amdgcn_readfirstlane(bx); u < 1024; u = __builtin_amdgcn_readfirstlane(u + G)) attn_unit(P, lds, misc, u >> 7, u & 127);
            xcd_barrier(bar);
        }
        E = Epi{}; E.mode = EM_RES;
        E.xs_c = l == 0 ? P.in[2] : xc; E.xs_x = l == 0 ? P.in[0] : P.out; E.xd_c = xc; E.xd_x = P.out;
        E.xrb = (bf16_t*)(P.ws + WS_XR); E.src_f32 = 0; E.dst_f32 = 0;
        E.gate_c = misc + OFF_MOD + (l * 2 + 1) * 6144 + 2048; E.gate_x = misc + OFF_MOD + (l * 2 + 0) * 6144 + 2048;
        E.gs_c = misc + OFF_GS + ((l * 2 + 1) * 2 + 1) * 1024; E.gs_x = misc + OFF_GS + ((l * 2 + 1) * 2 + 0) * 1024;
        E.ss_out = misc + OFF_SS + (1 + 2 * l) * MT; E.act0 = (bf16_t*)act0;
        S = pg8::Sched{act1, (const char*)(P.ws + (l == 0 ? W_O0 : W_O1)), nullptr, nullptr, l == 0 ? 65 : 64, 4, l == 0 ? 0 : 1, 0, 0, 1024, 0, G, bx, 1};
        if (PHMASK & 2) pg8::gemm_phase(lds, S, E);
        xcd_barrier(bar);
        E = Epi{}; E.mode = EM_UP; E.ss = misc + OFF_SS + (1 + 2 * l) * MT; E.bias0 = misc + OFF_BIAS + (l == 0 ? B_UP0 : B_UP1); E.nb0 = NUP;
        E.conv = P.in[27] + (size_t)l * 3 * NUP; E.convb = P.in[28] + (size_t)l * NUP; E.g = (bf16_t*)(P.ws + R_G);
        S = pg8::Sched{act0, (const char*)(P.ws + (l == 0 ? W_UP0 : W_UP1)), nullptr, nullptr, l == 0 ? 69 : 67, 22, l == 0 ? 0 : 2, 0, 0, 1024, 1, G, bx};
        if (PHMASK & 2) pg8::gemm_phase(lds, S, E);
        xcd_barrier(bar);
        E = Epi{}; E.mode = EM_RES;
        E.xs_c = xc; E.xs_x = P.out; E.xd_c = xc; E.xd_x = P.out;
        E.xrb = (bf16_t*)(P.ws + WS_XR); E.src_f32 = 0; E.dst_f32 = 0;
        E.gate_c = misc + OFF_MOD + (l * 2 + 1) * 6144 + 5120; E.gate_x = misc + OFF_MOD + (l * 2 + 0) * 6144 + 5120;
        E.gs_c = l == 0 ? misc + OFF_GS + ((1 * 2 + 0) * 2 + 1) * 1024 : nullptr; E.gs_x = l == 0 ? misc + OFF_GS + ((1 * 2 + 0) * 2 + 0) * 1024 : nullptr;
        E.ss_out = misc + OFF_SS + (2 + 2 * l) * MT; E.act0 = (bf16_t*)act0;
        S = pg8::Sched{(const char*)(P.ws + R_G), (const char*)(P.ws + (l == 0 ? W_DN0 : W_DN1)), nullptr, nullptr, l == 0 ? 65 : 64, 4, l == 0 ? 0 : 1, 0, 0, DFF, 0, G, bx, 1};
        if (PHMASK & 2) pg8::gemm_phase(lds, S, E);
        xcd_barrier(bar);
    }
    {
        int tid_ = threadIdx.x; asm volatile("" : "+v"(tid_));
        const int lane = tid_ & 63, gw = bx * 8 + (tid_ >> 6);
        for (int row0 = gw; row0 < LX; row0 += 2 * G * 8) {
            const int row1 = row0 + G * 8; const bool has1 = row1 < LX; const int r1 = has1 ? row1 : row0;
            const float rs0 = __builtin_amdgcn_rsqf(misc[OFF_SS + 4 * MT + 256 + row0] * (1.f / D) + EPS), rs1 = __builtin_amdgcn_rsqf(misc[OFF_SS + 4 * MT + 256 + r1] * (1.f / D) + EPS);
            f32x4 v0[4], v1[4];
#pragma unroll
            for (int j = 0; j < 4; ++j) { const int c = 4 * lane + 256 * j; const bf16_t* xr = (const bf16_t*)(P.ws + WS_XR);
                const u32x2 a0 = __builtin_nontemporal_load((const u32x2*)(xr + (size_t)(256 + row0) * D + c)), a1 = __builtin_nontemporal_load((const u32x2*)(xr + (size_t)(256 + r1) * D + c));
                v0[j] = (f32x4){bflo(a0.x), bfhi(a0.x), bflo(a0.y), bfhi(a0.y)}; v1[j] = (f32x4){bflo(a1.x), bfhi(a1.x), bflo(a1.y), bfhi(a1.y)}; }
#pragma unroll
            for (int j = 0; j < 4; ++j) { const int c = 4 * lane + 256 * j; const f32x4 fn = *(const f32x4*)(P.in[30] + c);
                __builtin_nontemporal_store(v0[j] * rs0 * fn, (f32x4*)(P.out + (size_t)row0 * D + c)); if (has1) __builtin_nontemporal_store(v1[j] * rs1 * fn, (f32x4*)(P.out + (size_t)row1 * D + c)); }
        }
    }
}

constexpr int LDS_BYTES = 147456;
extern "C" void kernel_launch(void* const* d_in, const int* in_sizes, int n_in, void* d_out, int out_size, void* d_ws, size_t ws_size, hipStream_t stream) {
    static int grid = 0;
    if (grid == 0) {
        int dev = 0, cus = 0, per_cu = 0;
        hipGetDevice(&dev);
        hipDeviceGetAttribute(&cus, hipDeviceAttributeMultiprocessorCount, dev);
        hipFuncSetAttribute((const void*)fwd_megakernel, hipFuncAttributeMaxDynamicSharedMemorySize, LDS_BYTES);
        hipOccupancyMaxActiveBlocksPerMultiprocessor(&per_cu, (const void*)fwd_megakernel, 512, LDS_BYTES);
        if (per_cu < 1) { fprintf(stderr, "kernel_launch: occupancy query says %d blocks/CU\n", per_cu); per_cu = 1; }
        grid = cus;
        if (ws_size < WS_END) { fprintf(stderr, "kernel_launch: workspace too small (%zu < %zu)\n", ws_size, (size_t)WS_END); grid = -1; }
        if (n_in != 31) { fprintf(stderr, "kernel_launch: expected 31 inputs, got %d\n", n_in); grid = -1; }
    }
    if (grid < 0) return;
    Params p{};
    for (int i = 0; i < 31; ++i) p.in[i] = (const float*)d_in[i];
    p.out = (float*)d_out; p.ws = (unsigned char*)d_ws;
    unsigned char* ws = (unsigned char*)d_ws;
    auto mk = [](const float* src, void* dst, int K, int Nsrc, int nrows, int map) { Piece q; q.src = src; q.dst = (bf16_t*)dst; q.K = K; q.Nsrc = Nsrc; q.nrows = nrows; q.map = map; return q; };
    p.pc[0] = mk(p.in[8], ws + W_P0, 1024, 512, 512, 0);
    p.pc[1] = mk(p.in[9], ws + W_P0 + (size_t)512 * 2048, 1024, 512, 512, 0);
    p.pc[2] = mk(p.in[11], ws + W_P0 + (size_t)1024 * 2048, 1024, 1024, 1024, 0);
    p.pc[3] = mk(p.in[10], ws + W_V0, 1024, 1024, 1024, 0);
    p.pc[4] = mk(p.in[16], ws + W_O0, 1024, 1024, 1024, 0);
    p.pc[5] = mk(p.in[26], ws + W_UP0, 1024, NUP, NUP, 1);
    p.pc[6] = mk(p.in[29], ws + W_DN0, DFF, 1024, 1024, 0);
    p.pc[7] = mk(p.in[17], ws + W_QK1, 1024, 1024, 1024, 2);
    p.pc[8] = mk(p.in[18], ws + W_QK1 + (size_t)1024 * 2048, 1024, 1024, 1024, 2);
    p.pc[9] = mk(p.in[19], ws + W_V1, 1024, 1024, 1024, 0);
    p.pc[10] = mk(p.in[25], ws + W_O1, 1024, 1024, 1024, 0);
    p.pc[11] = mk(p.in[26] + (size_t)1024 * NUP, ws + W_UP1, 1024, NUP, NUP, 1);
    p.pc[12] = mk(p.in[29] + (size_t)DFF * 1024, ws + W_DN1, DFF, 1024, 1024, 0);
    if (hipMemsetAsync((char*)d_ws + WS_BAR, 0, 16384, stream) != hipSuccess) { fprintf(stderr, "memset failed\n"); return; }
    void* args[] = {&p};
    hipError_t e = hipLaunchCooperativeKernel((const void*)fwd_megakernel, dim3(grid), dim3(512), args, LDS_BYTES, stream);
    if (e != hipSuccess) fprintf(stderr, "cooperative launch failed: %s (grid %d)\n", hipGetErrorString(e), grid);
}
```
